# Optimizing an MI355X kernel written in HIP

```python
import jax, jax.numpy as jnp
from jax import lax
import numpy as np

D_MODEL = 1024
BATCH = 8
SEQ = 4096
DEPTH = 1

POOL_WIDTH = 256
POOL_WINDOWS = (2, 4, 8, 16)
POOL_GROUPS = len(POOL_WINDOWS)
POOL_GROUP_DIM = POOL_WIDTH // POOL_GROUPS
MLA_HEADS = 6
QK_NOPE_DIM = 128
QK_ROPE_DIM = 64
QK_HEAD_DIM = QK_NOPE_DIM + QK_ROPE_DIM
V_HEAD_DIM = 128
Q_LORA_RANK = 512
KV_LORA_RANK = 256
ROPE_THETA = 10000.0
Q_BLOCK = 128
IN_WIDTH = POOL_WIDTH + Q_LORA_RANK + KV_LORA_RANK + QK_ROPE_DIM
MIX_WIDTH = POOL_WIDTH + MLA_HEADS * V_HEAD_DIM
N_GROUPS = 4
EXPERTS_PER_GROUP = 8
N_EXPERTS = N_GROUPS * EXPERTS_PER_GROUP
TOP_K = 2
D_EXPERT = 256
ROW_BLOCK = 128
N_MOD = 6
EPS = 1e-6

kernel_name = "hybrid_pool_mla_hmoe_adaln"


def rmsnorm(x, g):
    xf = x.astype(jnp.float32)
    y = xf * lax.rsqrt(jnp.mean(xf * xf, axis=-1, keepdims=True) + EPS)
    return (y * g.astype(jnp.float32)).astype(x.dtype)


def rope_tables(positions, dim):
    inv_freq = ROPE_THETA ** (-(jnp.arange(0, dim, 2, dtype=jnp.float32) / dim))
    ang = positions.astype(jnp.float32)[..., None] * inv_freq
    return jnp.cos(ang), jnp.sin(ang)


def apply_rope(x, cos, sin):
    xf = x.astype(jnp.float32)
    x1, x2 = jnp.split(xf, 2, axis=-1)
    return jnp.concatenate([x1 * cos - x2 * sin, x2 * cos + x1 * sin], axis=-1).astype(x.dtype)


def pool_mixer(p, w_pool, pool_scale):
    B, S, C = p.shape
    cs = jnp.cumsum(p.astype(jnp.float32), axis=1)
    t = jnp.arange(1, S + 1, dtype=jnp.float32)
    means = []
    for gi, w in enumerate(POOL_WINDOWS):
        cg = cs[..., gi * POOL_GROUP_DIM:(gi + 1) * POOL_GROUP_DIM]
        lagged = jnp.pad(cg, ((0, 0), (w, 0), (0, 0)))[:, :S]
        cnt = jnp.minimum(t, float(w))[None, :, None]
        means.append((cg - lagged) / cnt)
    pooled = jnp.concatenate(means, axis=-1).astype(p.dtype) - p
    y = jnp.einsum('bsgc,gcd->bsgd', pooled.reshape(B, S, POOL_GROUPS, POOL_GROUP_DIM), w_pool)
    return y.reshape(B, S, C) * pool_scale


def mla_attention(c_q, c_kv, k_rope_in, positions, q_norm_g, w_uq, kv_norm_g, w_ukv):
    B, S, _ = c_q.shape
    q = (rmsnorm(c_q, q_norm_g) @ w_uq).reshape(B, S, MLA_HEADS, QK_HEAD_DIM)
    q_nope, q_rope = q[..., :QK_NOPE_DIM], q[..., QK_NOPE_DIM:]
    kv = (rmsnorm(c_kv, kv_norm_g) @ w_ukv).reshape(B, S, MLA_HEADS, QK_NOPE_DIM + V_HEAD_DIM)
    k_nope, v = kv[..., :QK_NOPE_DIM], kv[..., QK_NOPE_DIM:]
    cos, sin = rope_tables(positions, QK_ROPE_DIM)
    q_rope = apply_rope(q_rope, cos[:, :, None, :], sin[:, :, None, :])
    k_rope = apply_rope(k_rope_in, cos, sin)
    scale = QK_HEAD_DIM ** -0.5
    key_idx = jnp.arange(S)

    def block(i):
        start = i * Q_BLOCK
        qn = lax.dynamic_slice_in_dim(q_nope, start, Q_BLOCK, axis=1)
        qr = lax.dynamic_slice_in_dim(q_rope, start, Q_BLOCK, axis=1)
        s = (jnp.einsum('bqhd,bkhd->bhqk', qn, k_nope)
             + jnp.einsum('bqhd,bkd->bhqk', qr, k_rope)).astype(jnp.float32) * scale
        q_idx = start + jnp.arange(Q_BLOCK)
        s = jnp.where(key_idx[None, :] <= q_idx[:, None], s, -jnp.inf)
        pr = jax.nn.softmax(s, axis=-1).astype(v.dtype)
        return jnp.einsum('bhqk,bkhd->bqhd', pr, v)

    out = lax.map(block, jnp.arange(S // Q_BLOCK))
    return out.transpose(1, 0, 2, 3, 4).reshape(B, S, MLA_HEADS * V_HEAD_DIM)


def hierarchical_moe(h, w_group, b_group, w_router, b_router, w_gate_up, w_down):
    B, S, D = h.shape
    N = B * S
    hf = h.reshape(N, D)
    g_logits = (hf @ w_group).astype(jnp.float32)
    g_prob = jax.nn.softmax(g_logits, axis=-1)
    g_sel = jnp.argmax(g_logits + b_group.astype(jnp.float32), axis=-1)
    e_logits = (hf @ w_router).astype(jnp.float32).reshape(N, N_GROUPS, EXPERTS_PER_GROUP)
    e_in = jnp.take_along_axis(e_logits, g_sel[:, None, None], axis=1)[:, 0]
    b_in = b_router.astype(jnp.float32).reshape(N_GROUPS, EXPERTS_PER_GROUP)[g_sel]
    _, local_idx = lax.top_k(e_in + b_in, TOP_K)
    sel_prob = jnp.take_along_axis(jax.nn.softmax(e_in, axis=-1), local_idx, axis=-1)
    sel_prob = sel_prob / jnp.sum(sel_prob, axis=-1, keepdims=True)
    gp = jnp.take_along_axis(g_prob, g_sel[:, None], axis=-1)
    weights = gp * sel_prob
    expert_ids = g_sel[:, None] * EXPERTS_PER_GROUP + local_idx

    P = N * TOP_K
    flat_e = expert_ids.reshape(P).astype(jnp.int32)
    flat_tok = jnp.repeat(jnp.arange(N, dtype=jnp.int32), TOP_K)
    flat_w = weights.reshape(P)
    order = jnp.argsort(flat_e)
    sorted_e = flat_e[order]
    counts = jnp.zeros((N_EXPERTS,), jnp.int32).at[flat_e].add(1)
    padded = ((counts + ROW_BLOCK - 1) // ROW_BLOCK) * ROW_BLOCK
    starts = jnp.cumsum(counts) - counts
    pends = jnp.cumsum(padded)
    pstarts = pends - padded
    dest = pstarts[sorted_e] + (jnp.arange(P, dtype=jnp.int32) - starts[sorted_e])
    P_pad = P + N_EXPERTS * ROW_BLOCK
    n_rb = P_pad // ROW_BLOCK
    row_tok = jnp.full((P_pad,), N, jnp.int32).at[dest].set(flat_tok[order])
    row_w = jnp.zeros((P_pad,), h.dtype).at[dest].set(flat_w[order].astype(h.dtype))
    block_e = jnp.searchsorted(pends, jnp.arange(n_rb, dtype=jnp.int32) * ROW_BLOCK, side='right')
    block_e = jnp.minimum(block_e, N_EXPERTS - 1)
    x_pad = jnp.concatenate([hf, jnp.zeros((1, D), hf.dtype)], axis=0)
    xs = x_pad[row_tok].reshape(n_rb, ROW_BLOCK, D)

    def expert_block(args):
        xb, e = args
        gu = xb @ w_gate_up[e]
        gate, up = gu[:, :D_EXPERT], gu[:, D_EXPERT:]
        return (jax.nn.silu(gate) * up) @ w_down[e]

    ys = lax.map(expert_block, (xs, block_e)).reshape(P_pad, D) * row_w[:, None]
    out = jax.ops.segment_sum(ys, row_tok, num_segments=N + 1)[:N]
    return out.reshape(B, S, D)


def setup_inputs(seed: int = 0) -> dict:
    key = jax.random.key(seed)
    ks = jax.random.split(key, 24)
    L, D = DEPTH, D_MODEL
    f32 = jnp.float32

    def nrm(k, shape, fan_in):
        return jax.random.normal(k, shape, f32) * (fan_in ** -0.5)

    def gain(k, shape):
        return 1.0 + 0.02 * jax.random.normal(k, shape, f32)

    x = jax.random.normal(ks[0], (BATCH, SEQ, D), f32)
    c = jax.random.normal(ks[1], (BATCH, D), f32)
    offsets = jax.random.randint(ks[2], (BATCH, 1), 0, 1024, jnp.int32)
    positions = (offsets + jnp.arange(SEQ, dtype=jnp.int32)[None, :]).astype(jnp.int32)
    return {
        "x": x,
        "c": c,
        "positions": positions,
        "w_mod": nrm(ks[3], (L, D, N_MOD * D), D),
        "b_mod": 0.02 * jax.random.normal(ks[4], (L, N_MOD * D), f32),
        "norm_mix_g": gain(ks[5], (L, D)),
        "w_in": nrm(ks[6], (L, D, IN_WIDTH), D),
        "w_pool": nrm(ks[7], (L, POOL_GROUPS, POOL_GROUP_DIM, POOL_GROUP_DIM), POOL_GROUP_DIM),
        "pool_scale": gain(ks[8], (L, POOL_WIDTH)),
        "q_norm_g": gain(ks[9], (L, Q_LORA_RANK)),
        "w_uq": nrm(ks[10], (L, Q_LORA_RANK, MLA_HEADS * QK_HEAD_DIM), Q_LORA_RANK),
        "kv_norm_g": gain(ks[11], (L, KV_LORA_RANK)),
        "w_ukv": nrm(ks[12], (L, KV_LORA_RANK, MLA_HEADS * (QK_NOPE_DIM + V_HEAD_DIM)), KV_LORA_RANK),
        "w_o": nrm(ks[13], (L, MIX_WIDTH, D), MIX_WIDTH),
        "norm_ffn_g": gain(ks[14], (L, D)),
        "w_group": nrm(ks[15], (L, D, N_GROUPS), D),
        "b_group": 0.01 * jax.random.normal(ks[16], (L, N_GROUPS), f32),
        "w_router": nrm(ks[17], (L, D, N_EXPERTS), D),
        "b_router": 0.01 * jax.random.normal(ks[18], (L, N_EXPERTS), f32),
        "w_gate_up": nrm(ks[19], (L, N_EXPERTS, D, 2 * D_EXPERT), D),
        "w_down": nrm(ks[20], (L, N_EXPERTS, D_EXPERT, D), D_EXPERT),
        "final_g": gain(ks[21], (D,)),
    }


def reference(x, c, positions, w_mod, b_mod, norm_mix_g, w_in, w_pool, pool_scale,
              q_norm_g, w_uq, kv_norm_g, w_ukv, w_o, norm_ffn_g, w_group, b_group,
              w_router, b_router, w_gate_up, w_down, final_g):
    c_act = jax.nn.silu(c)
    cut1 = POOL_WIDTH
    cut2 = cut1 + Q_LORA_RANK
    cut3 = cut2 + KV_LORA_RANK
    for l in range(DEPTH):
        mod = (c_act @ w_mod[l] + b_mod[l])[:, None, :]
        shift_a, scale_a, gate_a, shift_f, scale_f, gate_f = jnp.split(mod, N_MOD, axis=-1)
        h = rmsnorm(x, norm_mix_g[l]) * (1.0 + scale_a) + shift_a
        u = h @ w_in[l]
        y_pool = pool_mixer(u[..., :cut1], w_pool[l], pool_scale[l])
        y_mla = mla_attention(u[..., cut1:cut2], u[..., cut2:cut3], u[..., cut3:], positions,
                              q_norm_g[l], w_uq[l], kv_norm_g[l], w_ukv[l])
        mix = jnp.concatenate([y_pool, y_mla], axis=-1) @ w_o[l]
        x = x + gate_a * mix
        h = rmsnorm(x, norm_ffn_g[l]) * (1.0 + scale_f) + shift_f
        x = x + gate_f * hierarchical_moe(h, w_group[l], b_group[l], w_router[l], b_router[l],
                                          w_gate_up[l], w_down[l])
    return rmsnorm(x, final_g)
```

```cpp
#include <hip/hip_runtime.h>
#include <cstdio>
#include <cstdint>

#define LAS __attribute__((address_space(3)))
#define GAS __attribute__((address_space(1)))
typedef unsigned short bf16_t;
typedef short bf16x8 __attribute__((ext_vector_type(8)));
typedef short s16x4 __attribute__((ext_vector_type(4)));
typedef float f32x2 __attribute__((ext_vector_type(2)));
typedef float f32x4 __attribute__((ext_vector_type(4)));
typedef float f32x16 __attribute__((ext_vector_type(16)));
typedef unsigned u32x2 __attribute__((ext_vector_type(2)));
typedef unsigned u32x4 __attribute__((ext_vector_type(4)));
typedef __bf16 bf16x2_t __attribute__((ext_vector_type(2)));
typedef GAS unsigned gu32;

constexpr int NB = 8, SEQ = 4096, DM = 1024, NTOK = NB * SEQ;
constexpr int NH = 6, DQK = 192, DNOPE = 128, DROPE = 64, DV = 128;
constexpr int QLORA = 512, KVLORA = 256, POOLW = 256;
constexpr int INW = 1088, INW_PAD = 1280, UQW = 1152, UQW_PAD = 1280, UKVW = 1536;
constexpr int NEXP = 32, DEXP = 256, NMOD = 6;
constexpr float EPS = 1e-6f;
constexpr int MAXRT = 288;
constexpr int NWAVES = 8, NTHR = 512;

constexpr size_t MiB = 1u << 20;
constexpr size_t WS_CTL = 0, CTL_ZERO_BYTES = 65536;
constexpr size_t WS_MOD = 1 * MiB;
constexpr size_t WS_WIN = 2 * MiB;
constexpr size_t WS_WUQ = 5 * MiB;
constexpr size_t WS_WUKV = 7 * MiB;
constexpr size_t WS_WO = 8 * MiB;
constexpr size_t WS_WGU = 10 * MiB;
constexpr size_t WS_WD = 42 * MiB;
constexpr size_t WS_WR = 1 * MiB + 512 * 1024;
constexpr size_t WS_SSQQ = 58 * MiB;
constexpr size_t WS_SSQKV = 59 * MiB;
constexpr size_t WS_SSQX = 60 * MiB;
constexpr size_t WS_LTOK = 62 * MiB;
constexpr size_t WS_TINFO = 66 * MiB;
constexpr size_t WS_TW = 66 * MiB + 512 * 1024;
constexpr size_t WS_H = 68 * MiB;
constexpr size_t WS_P = 132 * MiB;
constexpr size_t WS_CQ = 148 * MiB;
constexpr size_t WS_CKV = 180 * MiB;
constexpr size_t WS_ACT = 132 * MiB;
constexpr size_t WS_Q = 196 * MiB;
constexpr size_t WS_K = 268 * MiB;
constexpr size_t WS_V = 340 * MiB;
constexpr size_t WS_YS = 196 * MiB;
constexpr size_t WS_MIX = 388 * MiB;
constexpr size_t WS_END = 452 * MiB;
static_assert(WS_ACT + (size_t)MAXRT * 256 * 256 * 2 <= WS_CKV && WS_YS + (size_t)MAXRT * 256 * 1024 * 2 <= WS_V, "overlays");
constexpr int CW_BAR = 4096;
constexpr int CW_ATTNQ = 8192;
constexpr int CW_ECNT = 8448;
static_assert((CW_ECNT + 64 * NEXP) * 4 <= (int)CTL_ZERO_BYTES, "CTL words inside the memset region");

constexpr int RING_BYTES = 131072;
constexpr int LX_BASE = RING_BYTES + 2048;
constexpr int LX_MISC = LX_BASE;
constexpr int LX_MBOX = LX_BASE + 64;
constexpr int LX_ECNT = LX_BASE + 256;
constexpr int LX_TBASE = LX_ECNT + 128;
constexpr int LX_TILEE = LX_TBASE + 256;
constexpr int LX_GTAB = LX_BASE + 4096;
constexpr int LDS_BYTES = RING_BYTES + 16384;
static_assert(LX_TILEE + MAXRT * 4 <= LX_GTAB && LX_GTAB + 4 * 1024 <= LDS_BYTES, "LDS map");

#define LDS_WAIT() asm volatile("s_waitcnt lgkmcnt(0)" ::: "memory")
#define VM_WAIT() asm volatile("s_waitcnt vmcnt(0)" ::: "memory")
#define SBAR() __builtin_amdgcn_sched_barrier(0)
__device__ __forceinline__ unsigned cvtpk(float lo, float hi) { f32x2 v = {lo, hi}; bf16x2_t b = __builtin_convertvector(v, bf16x2_t); return __builtin_bit_cast(unsigned, b); }
__device__ __forceinline__ float bf_lo(unsigned w) { return __uint_as_float(w << 16); }
__device__ __forceinline__ float bf_hi(unsigned w) { return __uint_as_float(w & 0xffff0000u); }
__device__ __forceinline__ float wave_sum(float v) {
#pragma unroll
    for (int o = 1; o < 64; o <<= 1) v += __shfl_xor(v, o);
    return v;
}
__device__ __forceinline__ void rope_cs(int pos, int i, float& c, float& s) {
    const float f = __builtin_amdgcn_exp2f(-0.41524101186092f * (float)i) * 0.15915494309189535f;
    const float p = (float)pos, hi = p * f, lo = __builtin_fmaf(p, f, -hi);
    float r = hi - __builtin_rintf(hi); r += lo;
    c = __builtin_amdgcn_cosf(r); s = __builtin_amdgcn_sinf(r);
}

namespace pg8 {
#define PG8_LAS __attribute__((address_space(3)))
typedef unsigned short bf16_t;
typedef short bf16x8 __attribute__((ext_vector_type(8)));
typedef float f32x4 __attribute__((ext_vector_type(4)));
typedef unsigned u32x4 __attribute__((ext_vector_type(4)));
constexpr int BM = 256, BK = 64, HALF = 128, HTB = HALF * BK * 2  , STAGE_BYTES = 8 * HTB, NXCD = 8, WGM = 8;

__host__ __device__ __forceinline__ int lds_byte(int r, int c) { const int st = (r >> 4) * 2 + (c >> 5), rr = r & 15, cc = c & 31, ob = rr * 64 + cc * 2; return st * 1024 + (ob ^ (((ob >> 9) & 1) << 5)); }
__host__ __device__ __forceinline__ void stage_rc(int b, int& R, int& C) { const int st = b / 1024, sb = b % 1024, swz = sb ^ (((sb >> 9) & 1) << 5); R = (st >> 1) * 16 + swz / 64; C = (st & 1) * 32 + (swz % 64) / 2; }
__host__ __device__ __forceinline__ int perm32(int rho) { const int n = rho >> 4, i = rho & 15; return 8 * (i >> 2) + 4 * n + (i & 3); }

struct Unit { int pm, pn; };
struct Gemm { const bf16_t* A; const bf16_t* Bt; int M, N, K; };

template <class Epi, class Sched, bool ALIGN_EPI = false, bool SP2 = false, bool GATHER = false>
__device__ __forceinline__ void gemm_phase(PG8_LAS unsigned char* lds, const Gemm g, const Sched& S, const Epi& E) {
    const int tid = threadIdx.x, wid = __builtin_amdgcn_readfirstlane(tid >> 6), lane = tid & 63, wr = wid >> 2, wc = wid & 3, fr = lane & 15, fq = lane >> 4;
    const int K = g.K, nt = K / BK;
    unsigned voffA[2], voffB[2];
#pragma unroll
    for (int i = 0; i < 2; ++i) { int R, C; stage_rc(tid * 16 + i * 8192, R, C); const int Rb = Epi::PERM ? ((R & ~31) + perm32(R & 31)) : R;
        voffA[i] = (unsigned)(R * K + C) * 2u; voffB[i] = (unsigned)(Rb * K + C) * 2u; }
    int gR0 = 0; unsigned gCb = 0; const PG8_LAS unsigned* gtab = nullptr;
    if constexpr (GATHER) { int R, C; stage_rc(tid * 16, R, C); gR0 = R; gCb = (unsigned)C * 2u; gtab = S.gtab(); }
    const size_t kstep = (size_t)(BK * 2);
    const size_t hstep = (size_t)HALF * K * 2;
    const size_t tstep = 2 * hstep;
    const unsigned ldsw = (unsigned)wid * 1024u;
    const int aoff = lds_byte(wr * 64 + fr, fq * 8), boff = lds_byte(wc * 32 + fr, fq * 8);
#define PG8_SA(b, h) (((b) * 2 + (h)) * HTB)
#define PG8_SB(b, h) ((4 + (b) * 2 + (h)) * HTB)
#define PG8_STAGE(bufoff, gbase, voff) do { _Pragma("unroll") for (int _i = 0; _i < 2; ++_i) \
        __builtin_amdgcn_global_load_lds((const unsigned*)((const char*)(gbase) + (voff)[_i]), (PG8_LAS unsigned*)(lds + (bufoff) + ldsw + _i * 8192), 16, 0, 0); } while (0)
#define PG8_STAGE_A(bufoff, ptr, us, half, kt) do { if constexpr (GATHER) { _Pragma("unroll") for (int _i = 0; _i < 2; ++_i) { const unsigned _o = gtab[(us) * 256 + (half) * 128 + gR0 + 64 * _i]; \
        __builtin_amdgcn_global_load_lds((const unsigned*)((const char*)g.A + _o + gCb + (size_t)(kt) * kstep), (PG8_LAS unsigned*)(lds + (bufoff) + ldsw + _i * 8192), 16, 0, 0); } } \
        else { PG8_STAGE(bufoff, ptr, voffA); } } while (0)
#define PG8_LDA(dst, b, h) do { _Pragma("unroll") for (int m = 0; m < 4; ++m) _Pragma("unroll") for (int k = 0; k < 2; ++k) dst[m][k] = *(const PG8_LAS bf16x8*)(lds + PG8_SA(b, h) + aoff + m * 2048 + k * 1024); } while (0)
#define PG8_LDB(dst, b, h) do { _Pragma("unroll") for (int n = 0; n < 2; ++n) _Pragma("unroll") for (int k = 0; k < 2; ++k) dst[n][k] = *(const PG8_LAS bf16x8*)(lds + PG8_SB(b, h) + boff + n * 2048 + k * 1024); } while (0)
#define PG8_MMA(ai, bj, At, Bt) do { __builtin_amdgcn_s_setprio(1); _Pragma("unroll") for (int m = 0; m < 4; ++m) _Pragma("unroll") for (int n = 0; n < 2; ++n) _Pragma("unroll") for (int k = 0; k < 2; ++k) \
        acc[ai][bj][m][n] = __builtin_amdgcn_mfma_f32_16x16x32_bf16(Bt[n][k], At[m][k], acc[ai][bj][m][n], 0, 0, 0); __builtin_amdgcn_s_setprio(0); } while (0)
#define PG8_WAIT_V(n) asm volatile("s_waitcnt vmcnt(" #n ")" ::: "memory")
#define PG8_WAIT_L(n) asm volatile("s_waitcnt lgkmcnt(" #n ")" ::: "memory")
#define PG8_BAR __builtin_amdgcn_s_barrier()
#define PG8_SCHED __builtin_amdgcn_sched_barrier(0)
    Unit cur, nxt; int ui = 0;
    if (!S.next(0, cur)) return;
    f32x4 acc[2][2][4][2];
#pragma unroll
    for (int a = 0; a < 2; ++a)
#pragma unroll
        for (int b = 0; b < 2; ++b)
#pragma unroll
            for (int m = 0; m < 4; ++m)
#pragma unroll
                for (int n = 0; n < 2; ++n) acc[a][b][m][n] = (f32x4){0.f, 0.f, 0.f, 0.f};
    bf16x8 At[4][2], B0[2][2], B1[2][2];
    const char* cA = (const char*)g.A + (size_t)cur.pm * tstep; const char* cB = (const char*)g.Bt + (size_t)cur.pn * tstep;
    S.a_ready(cur);
    if constexpr (SP2) {
        PG8_STAGE(PG8_SB(0, 0), cB, voffB); PG8_STAGE(PG8_SB(0, 1), cB + hstep, voffB); PG8_STAGE_A(PG8_SA(0, 0), cA, 0, 0, 0); PG8_STAGE_A(PG8_SA(0, 1), cA + hstep, 0, 1, 0);
        if (wr == 1) PG8_BAR;
        PG8_WAIT_V(2); PG8_BAR;
        PG8_STAGE(PG8_SB(1, 0), cB + kstep, voffB); PG8_STAGE_A(PG8_SA(1, 0), cA + kstep, 0, 0, 1); PG8_STAGE(PG8_SB(1, 1), cB + hstep + kstep, voffB);
        PG8_WAIT_V(6); PG8_BAR;
    } else {
        PG8_STAGE(PG8_SB(0, 0), cB, voffB); PG8_STAGE_A(PG8_SA(0, 0), cA, 0, 0, 0); PG8_STAGE(PG8_SB(0, 1), cB + hstep, voffB); PG8_STAGE_A(PG8_SA(0, 1), cA + hstep, 0, 1, 0);
        if (wr == 1) PG8_BAR;
        PG8_WAIT_V(4); PG8_BAR;
        PG8_STAGE(PG8_SB(1, 0), cB + kstep, voffB); PG8_STAGE_A(PG8_SA(1, 0), cA + kstep, 0, 0, 1); PG8_STAGE(PG8_SB(1, 1), cB + hstep + kstep, voffB);
        PG8_WAIT_V(6); PG8_BAR;
    }
    for (;;) {
        const bool has_next = S.next(ui + 1, nxt);
        const char* nA = has_next ? (const char*)g.A + (size_t)nxt.pm * tstep : cA; const char* nB = has_next ? (const char*)g.Bt + (size_t)nxt.pn * tstep : cB;
#pragma nounroll
        for (int t = 0; t < nt; t += 2) {
            const bool last = (t == nt - 2);
            const int us2 = (last && has_next) ? ui + 1 : ui, kt2 = last ? 0 : t + 2;
            const char* a1 = cA + (size_t)(t + 1) * kstep;
            const char* a2 = last ? nA : cA + (size_t)(t + 2) * kstep; const char* b2 = last ? nB : cB + (size_t)(t + 2) * kstep;
            const char* a3 = a2 + kstep; const char* b3 = b2 + kstep;
            if (last && has_next) S.a_ready(nxt);
            if constexpr (SP2) {
            PG8_LDB(B0, 0, 0); PG8_LDB(B1, 0, 1); PG8_SCHED; PG8_LDA(At, 0, 0); PG8_STAGE_A(PG8_SA(1, 1), a1 + hstep, ui, 1, t + 1);
            PG8_WAIT_V(8); PG8_WAIT_L(0); PG8_BAR; PG8_MMA(0, 0, At, B0); PG8_MMA(0, 1, At, B1); PG8_BAR; PG8_SCHED;
            PG8_LDA(At, 0, 1); PG8_STAGE(PG8_SB(0, 0), b2, voffB); PG8_STAGE(PG8_SB(0, 1), b2 + hstep, voffB); PG8_STAGE_A(PG8_SA(0, 0), a2, us2, 0, kt2);
            PG8_WAIT_V(8); PG8_WAIT_L(0); PG8_BAR; PG8_MMA(1, 0, At, B0); PG8_MMA(1, 1, At, B1); PG8_BAR; PG8_SCHED;
            PG8_LDB(B0, 1, 0); PG8_LDB(B1, 1, 1); PG8_SCHED; PG8_LDA(At, 1, 0); PG8_STAGE_A(PG8_SA(0, 1), a2 + hstep, us2, 1, kt2);
            PG8_WAIT_V(8); PG8_WAIT_L(0); PG8_BAR; PG8_MMA(0, 0, At, B0); PG8_MMA(0, 1, At, B1); PG8_BAR; PG8_SCHED;
            PG8_LDA(At, 1, 1); PG8_STAGE(PG8_SB(1, 0), b3, voffB); PG8_STAGE(PG8_SB(1, 1), b3 + hstep, voffB); PG8_STAGE_A(PG8_SA(1, 0), a3, us2, 0, kt2 + 1);
            PG8_WAIT_V(8); PG8_WAIT_L(0); PG8_BAR; PG8_MMA(1, 0, At, B0); PG8_MMA(1, 1, At, B1); PG8_BAR; PG8_SCHED;
            } else {
            PG8_LDB(B0, 0, 0); PG8_SCHED; PG8_LDA(At, 0, 0); PG8_STAGE_A(PG8_SA(1, 1), a1 + hstep, ui, 1, t + 1);
            PG8_WAIT_L(8); PG8_BAR; PG8_WAIT_L(0); PG8_MMA(0, 0, At, B0); PG8_BAR; PG8_SCHED;
            PG8_LDB(B1, 0, 1); PG8_STAGE(PG8_SB(0, 0), b2, voffB);
            PG8_BAR; PG8_WAIT_L(0); PG8_MMA(0, 1, At, B1); PG8_BAR;
            PG8_LDA(At, 0, 1); PG8_STAGE_A(PG8_SA(0, 0), a2, us2, 0, kt2);
            PG8_BAR; PG8_WAIT_L(0); PG8_MMA(1, 0, At, B0); PG8_BAR; PG8_SCHED;
            PG8_STAGE(PG8_SB(0, 1), b2 + hstep, voffB);
            PG8_WAIT_V(6); PG8_BAR; PG8_MMA(1, 1, At, B1); PG8_BAR;
            PG8_LDB(B0, 1, 0); PG8_SCHED; PG8_LDA(At, 1, 0); PG8_STAGE_A(PG8_SA(0, 1), a2 + hstep, us2, 1, kt2);
            PG8_WAIT_L(8); PG8_BAR; PG8_WAIT_L(0); PG8_MMA(0, 0, At, B0); PG8_BAR; PG8_SCHED;
            PG8_LDB(B1, 1, 1); PG8_STAGE(PG8_SB(1, 0), b3, voffB);
            PG8_BAR; PG8_WAIT_L(0); PG8_MMA(0, 1, At, B1); PG8_BAR;
            PG8_LDA(At, 1, 1); PG8_STAGE_A(PG8_SA(1, 0), a3, us2, 0, kt2 + 1);
            PG8_BAR; PG8_WAIT_L(0); PG8_MMA(1, 0, At, B0); PG8_BAR; PG8_SCHED;
            PG8_STAGE(PG8_SB(1, 1), b3 + hstep, voffB);
            PG8_WAIT_V(6); PG8_BAR; PG8_MMA(1, 1, At, B1); PG8_BAR;
            }
        }
        if constexpr (ALIGN_EPI) { if (wr == 0) PG8_BAR; }
        if constexpr (!Epi::AFTER_DRAIN) { E(acc, cur, wr, wc, fr, fq); S.done(cur); }
        if (!has_next) break;
#pragma unroll
        for (int a = 0; a < 2; ++a)
#pragma unroll
            for (int b = 0; b < 2; ++b)
#pragma unroll
                for (int m = 0; m < 4; ++m)
#pragma unroll
                    for (int n = 0; n < 2; ++n) acc[a][b][m][n] = (f32x4){0.f, 0.f, 0.f, 0.f};
        cur = nxt; cA = nA; cB = nB; ++ui;
        if constexpr (ALIGN_EPI) { if (wr == 1) PG8_BAR; }
    }
    PG8_WAIT_V(0);
    if constexpr (!ALIGN_EPI) { if (wr == 0) PG8_BAR; }
    PG8_BAR;
    if constexpr (Epi::AFTER_DRAIN) { E.fused(acc, cur, wr, wc, fr, fq, lds, wid, lane); S.done(cur); }
#undef PG8_SA
#undef PG8_SB
#undef PG8_STAGE
#undef PG8_STAGE_A
#undef PG8_LDA
#undef PG8_LDB
#undef PG8_MMA
#undef PG8_WAIT_V
#undef PG8_WAIT_L
#undef PG8_BAR
#undef PG8_SCHED
}
}

#define XB_TMO      128
#define XB_XCNT(j)  (256  + 64 * (j))
#define XB_XSUB(j)  (1280 + 64 * (j))
#define XB_XGEN(j)  (2304 + 64 * (j))
#define XB_TOP      3328
#define XB_TOPGEN   3392
#define XCD_BAR_WORDS 3456
#define XB_SPIN_CAP (1u << 18)

__device__ __forceinline__ unsigned xb_ld(unsigned* p)              { return __hip_atomic_load(p, __ATOMIC_RELAXED, __HIP_MEMORY_SCOPE_AGENT); }
__device__ __forceinline__ unsigned xb_add(unsigned* p, unsigned v) { return __hip_atomic_fetch_add(p, v, __ATOMIC_RELAXED, __HIP_MEMORY_SCOPE_AGENT); }
__device__ __forceinline__ unsigned xb_xcc_id() { return (unsigned)__builtin_amdgcn_s_getreg((3 << 11) | 20) & 0xFu; }
#define XB_SPIN(cond, bar) do { unsigned _sp = 0; while (cond) { __builtin_amdgcn_s_sleep(1); \
    if ((++_sp & 255u) == 0u) { if (xb_ld(&(bar)[XB_TMO])) break; if (_sp > XB_SPIN_CAP) { atomicAdd(&(bar)[XB_TMO], 1u); break; } } } } while (0)

struct XcdBarrier {
    unsigned* bar; unsigned x;
    volatile LAS unsigned* st;
};

__device__ __forceinline__ XcdBarrier xcd_barrier_post(unsigned* bar, volatile LAS unsigned* st) {
    XcdBarrier b; b.bar = bar; b.x = xb_xcc_id(); b.st = st;
    if (threadIdx.x == 0) (void)xb_add(&bar[XB_XCNT(b.x)], 1u);
    return b;
}
__device__ __forceinline__ void xcd_barrier_complete(unsigned* bar, unsigned x, unsigned& nloc, unsigned& nx) {
    const unsigned G = gridDim.x * gridDim.y * gridDim.z;
    unsigned sum, cnt, mine, sp = 0u;
    for (;;) {
        sum = 0u; cnt = 0u; mine = 0u;
#pragma unroll
        for (unsigned j = 0; j < 16; ++j) { const unsigned c = xb_ld(&bar[XB_XCNT(j)]); sum += c; cnt += (c > 0u) ? 1u : 0u; mine = (j == x) ? c : mine; }
        if (sum == G) break;
        __builtin_amdgcn_s_sleep(1);
        if ((++sp & 255u) == 0u) { if (xb_ld(&bar[XB_TMO])) break; if (sp > XB_SPIN_CAP) { atomicAdd(&bar[XB_TMO], 1u); break; } }
    }
    nloc = mine > 0u ? mine : 1u; nx = cnt > 0u ? cnt : 1u;
}

__device__ __forceinline__ void xcd_barrier(const XcdBarrier& b) {
    asm volatile("s_waitcnt vmcnt(0)" ::: "memory");
    __syncthreads();
    if (threadIdx.x == 0) {
        unsigned* bar = b.bar;
        __builtin_amdgcn_s_waitcnt(0);
        unsigned nloc = b.st[0], nx = b.st[1];
        if (nloc == 0u) { xcd_barrier_complete(bar, b.x, nloc, nx); b.st[0] = nloc; b.st[1] = nx; }
        const unsigned old = xb_add(&bar[XB_XSUB(b.x)], 1u);
        const unsigned gen = old / nloc;
        if (old + 1u == (gen + 1u) * nloc) {
            __builtin_amdgcn_fence(__ATOMIC_RELEASE, "agent");
            asm volatile("s_waitcnt vmcnt(0)" ::: "memory");
            const unsigned og = xb_add(&bar[XB_TOP], 1u);
            const unsigned tg = og / nx;
            if (og + 1u == (tg + 1u) * nx) xb_add(&bar[XB_TOPGEN], 1u);
            else XB_SPIN(xb_ld(&bar[XB_TOPGEN]) == tg, bar);
            __builtin_amdgcn_fence(__ATOMIC_ACQUIRE, "agent");
            xb_add(&bar[XB_XGEN(b.x)], 1u);
            asm volatile("s_waitcnt vmcnt(0)" ::: "memory");
        } else {
            XB_SPIN(xb_ld(&bar[XB_XGEN(b.x)]) == gen, bar);
            __builtin_amdgcn_fence(__ATOMIC_ACQUIRE, "agent");
            asm volatile("s_waitcnt vmcnt(0)" ::: "memory");
        }
    }
    __syncthreads();
}


struct Args { const float* in[22]; float* out; unsigned char* ws; int ph_lo, ph_hi; };
static_assert(sizeof(Args) == 22 * 8 + 8 + 8 + 8, "Args has no padding");

struct DenseOrder {
    int nN, total, G, c;
    __device__ __forceinline__ bool next(int i, pg8::Unit& u) const { const int L = i * G + c; if (L >= total) return false; u.pm = L / nN; u.pn = L - u.pm * nN; return true; }
    __device__ __forceinline__ void a_ready(const pg8::Unit&) const {}
    __device__ __forceinline__ void done(const pg8::Unit&) const {}
};
struct MoeOrder {
    int NPN, total, G, c; const LAS int* tile_e; const LAS unsigned* tab;
    __device__ __forceinline__ bool next(int i, pg8::Unit& u) const { const int L = i * G + c; if (L >= total) return false; const int rt = L / NPN; u.pm = rt; u.pn = tile_e[rt] * NPN + (L - rt * NPN); return true; }
    __device__ __forceinline__ void a_ready(const pg8::Unit&) const {}
    __device__ __forceinline__ void done(const pg8::Unit&) const {}
    __device__ __forceinline__ const LAS unsigned* gtab() const { return tab; }
};

struct KvOrder {
    int G, c;
    __device__ __forceinline__ bool next(int i, pg8::Unit& u) const { int L;
        if (G == 256) { if (i < 2) L = i * 256 + c; else if (c >= 128 && i < 4) L = 512 + (i - 2) * 128 + (c - 128); else return false; }
        else { L = i * G + c; if (L >= (NTOK / 256) * 6) return false; }
        u.pm = L / 6; u.pn = L - u.pm * 6; return true; }
    __device__ __forceinline__ void a_ready(const pg8::Unit&) const {}
    __device__ __forceinline__ void done(const pg8::Unit&) const {}
};

typedef f32x4 Acc[2][2][4][2];
__device__ __forceinline__ u32x4 pack8(const f32x4 a, const f32x4 b) { u32x4 w; w.x = cvtpk(a[0], a[1]); w.y = cvtpk(a[2], a[3]); w.z = cvtpk(b[0], b[1]); w.w = cvtpk(b[2], b[3]); return w; }
__device__ __forceinline__ float dot4(const f32x4 a) { return (a[0] * a[0] + a[1] * a[1]) + (a[2] * a[2] + a[3] * a[3]); }
__device__ __forceinline__ void rope8(f32x4& v0, f32x4& v1, int pos, int i0) {
    float c, s;
    rope_cs(pos, i0, c, s);     { const float a = v0[0], b = v0[1]; v0[0] = a * c - b * s; v0[1] = b * c + a * s; }
    rope_cs(pos, i0 + 1, c, s); { const float a = v0[2], b = v0[3]; v0[2] = a * c - b * s; v0[3] = b * c + a * s; }
    rope_cs(pos, i0 + 2, c, s); { const float a = v1[0], b = v1[1]; v1[0] = a * c - b * s; v1[1] = b * c + a * s; }
    rope_cs(pos, i0 + 3, c, s); { const float a = v1[2], b = v1[3]; v1[2] = a * c - b * s; v1[3] = b * c + a * s; }
}

struct EpiU {
    static constexpr bool PERM = true, AFTER_DRAIN = false;
    bf16_t* P; bf16_t* CQ; bf16_t* CKV; float* ssq_q; float* ssq_kv;
    __device__ __forceinline__ void operator()(const Acc& acc, const pg8::Unit& u, int wr, int wc, int fr, int fq) const {
        const int pn = u.pn, row0 = u.pm * 256 + wr * 64 + fr, cl = wc * 32 + 8 * fq;
        bf16_t* O; int ld, cbase; float* sq = nullptr; int nslot = 0, slot = 0;
        if (pn == 0) { O = P; ld = POOLW; cbase = 0; }
        else if (pn < 3) { O = CQ; ld = QLORA; cbase = (pn - 1) * 256; sq = ssq_q; nslot = 8; slot = (pn - 1) * 4 + wc; }
        else { O = CKV; ld = KVLORA; cbase = 0; sq = ssq_kv; nslot = 4; slot = wc; }
#pragma unroll
        for (int ai = 0; ai < 2; ++ai)
#pragma unroll
            for (int m = 0; m < 4; ++m) { const int row = row0 + ai * 128 + m * 16; float s = 0.f;
#pragma unroll
                for (int bj = 0; bj < 2; ++bj) { const f32x4 v0 = acc[ai][bj][m][0], v1 = acc[ai][bj][m][1]; s += dot4(v0) + dot4(v1);
                    *(u32x4*)(O + (size_t)row * ld + cbase + bj * 128 + cl) = pack8(v0, v1); }
                if (sq) { s += __shfl_xor(s, 16); s += __shfl_xor(s, 32); if (fq == 0) sq[(size_t)row * nslot + slot] = s; } }
    }
};
struct EpiQ {
    static constexpr bool PERM = true, AFTER_DRAIN = false;
    bf16_t* Q; const float* ssq_q; const int* pos;
    __device__ __forceinline__ void operator()(const Acc& acc, const pg8::Unit& u, int wr, int wc, int fr, int fq) const {
        const int row0 = u.pm * 256 + wr * 64 + fr; constexpr float C2S = 0.07216878364870322f * 1.4426950408889634f;
#pragma unroll
        for (int ai = 0; ai < 2; ++ai)
#pragma unroll
            for (int m = 0; m < 4; ++m) { const int row = row0 + ai * 128 + m * 16; const f32x4 s0 = *(const f32x4*)(ssq_q + (size_t)row * 8), s1 = *(const f32x4*)(ssq_q + (size_t)row * 8 + 4);
                const float ss = ((s0[0] + s0[1]) + (s0[2] + s0[3])) + ((s1[0] + s1[1]) + (s1[2] + s1[3]));
                const float rs = C2S / sqrtf(ss * (1.f / QLORA) + EPS); const int b = row / SEQ, s = row - b * SEQ; const int p = pos[row];
#pragma unroll
                for (int bj = 0; bj < 2; ++bj) { const int c0 = u.pn * 256 + bj * 128 + wc * 32 + 8 * fq; if (c0 >= UQW) continue;
                    const int h = c0 / DQK, d = c0 - h * DQK; f32x4 v0 = acc[ai][bj][m][0] * rs, v1 = acc[ai][bj][m][1] * rs;
                    if (d >= DNOPE) rope8(v0, v1, p, (d - DNOPE) >> 1);
                    *(u32x4*)(Q + ((size_t)(b * NH + h) * SEQ + s) * DQK + d) = pack8(v0, v1); } }
    }
};
struct EpiKV {
    static constexpr bool PERM = true, AFTER_DRAIN = false;
    bf16_t* Kb; bf16_t* Vb; const float* ssq_kv;
    __device__ __forceinline__ void operator()(const Acc& acc, const pg8::Unit& u, int wr, int wc, int fr, int fq) const {
        const int row0 = u.pm * 256 + wr * 64 + fr, h = u.pn, d = wc * 32 + 8 * fq;
#pragma unroll
        for (int ai = 0; ai < 2; ++ai)
#pragma unroll
            for (int m = 0; m < 4; ++m) { const int row = row0 + ai * 128 + m * 16; const f32x4 s0 = *(const f32x4*)(ssq_kv + (size_t)row * 4);
                const float rs = 1.f / sqrtf(((s0[0] + s0[1]) + (s0[2] + s0[3])) * (1.f / KVLORA) + EPS); const int b = row / SEQ, s = row - b * SEQ; const size_t tr = (size_t)(b * NH + h) * SEQ + s;
                *(u32x4*)(Kb + tr * DQK + d) = pack8(acc[ai][0][m][0] * rs, acc[ai][0][m][1] * rs);
                *(u32x4*)(Vb + tr * DV + d) = pack8(acc[ai][1][m][0] * rs, acc[ai][1][m][1] * rs); }
    }
};
struct EpiO {
    static constexpr bool PERM = false, AFTER_DRAIN = false;
    const float* x; float* x1; const float* gate; float* ssq;
    __device__ __forceinline__ void operator()(const Acc& acc, const pg8::Unit& u, int wr, int wc, int fr, int fq) const {
        const int row0 = u.pm * 256 + wr * 64 + fr, col0 = u.pn * 256 + wc * 32 + 4 * fq, b = (u.pm * 256) / SEQ;
        f32x4 gv[2][2];
#pragma unroll
        for (int bj = 0; bj < 2; ++bj)
#pragma unroll
            for (int n = 0; n < 2; ++n) gv[bj][n] = *(const f32x4*)(gate + (size_t)b * (NMOD * DM) + col0 + bj * 128 + n * 16);
#pragma unroll
        for (int ai = 0; ai < 2; ++ai)
#pragma unroll
            for (int m = 0; m < 4; ++m) { const int row = row0 + ai * 128 + m * 16; const size_t off = (size_t)row * DM + col0; float s = 0.f;
#pragma unroll
                for (int bj = 0; bj < 2; ++bj)
#pragma unroll
                    for (int n = 0; n < 2; ++n) { const f32x4 xv = *(const f32x4*)(x + off + bj * 128 + n * 16); const f32x4 o = xv + gv[bj][n] * acc[ai][bj][m][n]; s += dot4(o);
                        *(f32x4*)(x1 + off + bj * 128 + n * 16) = o; }
                s += __shfl_xor(s, 16); s += __shfl_xor(s, 32); if (fq == 0) ssq[(size_t)row * 16 + u.pn * 4 + wc] = s; }
    }
};
struct EpiGU {
    static constexpr bool PERM = true, AFTER_DRAIN = false;
    bf16_t* ACT;
    __device__ __forceinline__ void operator()(const Acc& acc, const pg8::Unit& u, int wr, int wc, int fr, int fq) const {
        const int row0 = u.pm * 256 + wr * 64 + fr, col = (u.pn & 1) * 128 + wc * 32 + 8 * fq;
#pragma unroll
        for (int ai = 0; ai < 2; ++ai)
#pragma unroll
            for (int m = 0; m < 4; ++m) { const int row = row0 + ai * 128 + m * 16; f32x4 o[2];
#pragma unroll
                for (int n = 0; n < 2; ++n) { const f32x4 g = acc[ai][0][m][n], v = acc[ai][1][m][n];
#pragma unroll
                    for (int e = 0; e < 4; ++e) o[n][e] = g[e] / (1.f + __expf(-g[e])) * v[e]; }
                *(u32x4*)(ACT + (size_t)row * DEXP + col) = pack8(o[0], o[1]); }
    }
};
struct EpiDown {
    static constexpr bool PERM = true, AFTER_DRAIN = false;
    bf16_t* YS;
    __device__ __forceinline__ void operator()(const Acc& acc, const pg8::Unit& u, int wr, int wc, int fr, int fq) const {
        const int row0 = u.pm * 256 + wr * 64 + fr, col = (u.pn & 3) * 256 + wc * 32 + 8 * fq;
#pragma unroll
        for (int ai = 0; ai < 2; ++ai)
#pragma unroll
            for (int m = 0; m < 4; ++m) { const int row = row0 + ai * 128 + m * 16;
#pragma unroll
                for (int bj = 0; bj < 2; ++bj) *(u32x4*)(YS + (size_t)row * DM + col + bj * 128) = pack8(acc[ai][bj][m][0], acc[ai][bj][m][1]); }
    }
};

namespace att {
constexpr int QB = 256, KVBLK = 64, KPITCH = 400;
constexpr int SHM_V = KVBLK * DV * 2, SHM_K = KVBLK * KPITCH;
constexpr int OFF_V = 0, OFF_K = 3 * SHM_V, OFF_WS = OFF_K + 2 * SHM_K;
constexpr int LDS_NEED = OFF_WS + 8 * 64 * 4;
static_assert(LDS_NEED <= RING_BYTES, "attention scratch inside the ring");
constexpr float THR = 11.0f;
constexpr int NUNIT = NB * NH * (SEQ / QB);

__device__ __forceinline__ int v_st(int k, int c) { const int kk = (k & ~0xC) | ((k & 4) << 1) | ((k & 8) >> 1); return ((kk >> 3) * 4 + (c >> 5)) * 512 + ((kk & 7) * 32 + (c & 31)) * 2; }
__device__ __forceinline__ int v_rd_base(int lane) { return ((lane & 3) << 3) | (((lane >> 2) & 3) << 6) | (((lane >> 4) & 1) << 5) | (((lane >> 5) & 1) << 8); }
constexpr int v_rd_off(int d0, int ks, int half) { return d0 * 512 + ks * 4096 + half * 2048; }
__device__ __forceinline__ int crow(int r, int hi) { return (r & 3) + 8 * (r >> 2) + 4 * hi; }

__device__ __forceinline__ void mask_tile(f32x16& p0, f32x16& p1, int dq) {
    const float NEG = -__builtin_inff();
#pragma unroll
    for (int r = 0; r < 16; ++r) { const int c = (r & 3) + 8 * (r >> 2); if (dq - c < 0) p0[r] = NEG; if (dq - c - 32 < 0) p1[r] = NEG; }
}
__device__ __forceinline__ void softmax_tile(f32x16& p0, f32x16& p1, float& m_reg, float& alpha, float& l_reg, bf16x8& pa0, bf16x8& pa1, bf16x8& pa2, bf16x8& pa3) {
    float pmax = p0[0];
#pragma unroll
    for (int r = 1; r < 16; ++r) pmax = fmaxf(pmax, p0[r]);
#pragma unroll
    for (int r = 0; r < 16; ++r) pmax = fmaxf(pmax, p1[r]);
    { auto rr = __builtin_amdgcn_permlane32_swap(__float_as_uint(pmax), __float_as_uint(pmax), false, false); pmax = fmaxf(__uint_as_float(rr[0]), __uint_as_float(rr[1])); }
    float mn;
    if (__builtin_expect(__all(pmax - m_reg <= THR), 1)) { mn = m_reg; alpha = 1.f; }
    else { mn = fmaxf(m_reg, pmax); alpha = __builtin_amdgcn_exp2f(m_reg - mn); m_reg = mn; }
#pragma unroll
    for (int r = 0; r < 16; ++r) { p0[r] = __builtin_amdgcn_exp2f(p0[r] - mn); p1[r] = __builtin_amdgcn_exp2f(p1[r] - mn); }
    float ps = 0.f;
#pragma unroll
    for (int r = 0; r < 16; ++r) ps += p0[r];
#pragma unroll
    for (int r = 0; r < 16; ++r) ps += p1[r];
    { auto rr = __builtin_amdgcn_permlane32_swap(__float_as_uint(ps), __float_as_uint(ps), false, false); ps = __uint_as_float(rr[0]) + __uint_as_float(rr[1]); }
    l_reg = l_reg * alpha + ps;
#define PK4(P, B_, OUT) do { unsigned a0 = cvtpk(P[B_+0], P[B_+1]), a1 = cvtpk(P[B_+2], P[B_+3]); unsigned b0 = cvtpk(P[B_+4], P[B_+5]), b1 = cvtpk(P[B_+6], P[B_+7]); \
        auto r0 = __builtin_amdgcn_permlane32_swap(a0, b0, false, false); auto r1 = __builtin_amdgcn_permlane32_swap(a1, b1, false, false); \
        u32x4 w = {r0[0], r1[0], r0[1], r1[1]}; OUT = __builtin_bit_cast(bf16x8, w); } while (0)
    PK4(p0, 0, pa0); PK4(p0, 8, pa1); PK4(p1, 0, pa2); PK4(p1, 8, pa3);
#undef PK4
}
__device__ __forceinline__ void qkt(f32x16& p0, f32x16& p1, const LAS unsigned char* kb, const bf16x8* qr) {
    p0 = f32x16{}; p1 = f32x16{};
#pragma unroll
    for (int d0 = 0; d0 < 12; ++d0) {
        const bf16x8 b0 = *(const LAS bf16x8*)(kb + d0 * 32);
        const bf16x8 b1 = *(const LAS bf16x8*)(kb + d0 * 32 + 32 * KPITCH);
        p0 = __builtin_amdgcn_mfma_f32_32x32x16_bf16(b0, qr[d0], p0, 0, 0, 0);
        p1 = __builtin_amdgcn_mfma_f32_32x32x16_bf16(b1, qr[d0], p1, 0, 0, 0); }
}
__device__ __forceinline__ void pv_tile(f32x16* o, int vb, bf16x8 pa0, bf16x8 pa1, bf16x8 pa2, bf16x8 pa3) {
#define TRRD(dst, off) asm volatile("ds_read_b64_tr_b16 %0, %1 offset:%2" : "=&v"(dst) : "v"(vb), "i"(off) : "memory")
#define PV_D0(d0) do { s16x4 l0, l1, l2, l3, h0, h1, h2, h3; constexpr int b_ = v_rd_off(d0, 0, 0); \
        TRRD(l0, b_); TRRD(h0, b_ + 2048); TRRD(l1, b_ + 4096); TRRD(h1, b_ + 6144); TRRD(l2, b_ + 8192); TRRD(h2, b_ + 10240); TRRD(l3, b_ + 12288); TRRD(h3, b_ + 14336); \
        asm volatile("s_waitcnt lgkmcnt(0)" ::: "memory"); SBAR(); \
        o[d0] = __builtin_amdgcn_mfma_f32_32x32x16_bf16(pa0, (bf16x8){l0[0], l0[1], l0[2], l0[3], h0[0], h0[1], h0[2], h0[3]}, o[d0], 0, 0, 0); \
        o[d0] = __builtin_amdgcn_mfma_f32_32x32x16_bf16(pa1, (bf16x8){l1[0], l1[1], l1[2], l1[3], h1[0], h1[1], h1[2], h1[3]}, o[d0], 0, 0, 0); \
        o[d0] = __builtin_amdgcn_mfma_f32_32x32x16_bf16(pa2, (bf16x8){l2[0], l2[1], l2[2], l2[3], h2[0], h2[1], h2[2], h2[3]}, o[d0], 0, 0, 0); \
        o[d0] = __builtin_amdgcn_mfma_f32_32x32x16_bf16(pa3, (bf16x8){l3[0], l3[1], l3[2], l3[3], h3[0], h3[1], h3[2], h3[3]}, o[d0], 0, 0, 0); } while (0)
    PV_D0(0); PV_D0(1); PV_D0(2); PV_D0(3);
#undef PV_D0
#undef TRRD
}

__device__ __forceinline__ void attn_unit(int bh, int qb, const bf16_t* __restrict__ Q, const bf16_t* __restrict__ K, const bf16_t* __restrict__ V, bf16_t* MIX, LAS unsigned char* lds) {
    const int tid = threadIdx.x, wid = __builtin_amdgcn_readfirstlane(tid >> 6), lane = tid & 63, r32 = lane & 31, hi = lane >> 5;
    const int NT = 4 * qb + 4;
    const bf16_t* Qh = Q + ((size_t)bh * SEQ + (size_t)qb * QB) * DQK; const bf16_t* Kh = K + (size_t)bh * SEQ * DQK; const bf16_t* Vh = V + (size_t)bh * SEQ * DV;
    LAS float* ws = (LAS float*)(lds + OFF_WS) + wid * 64; LAS float* li_l = ws; LAS float* al_l = ws + 32;
    bf16x8 qr[12];
#pragma unroll
    for (int d0 = 0; d0 < 12; ++d0) qr[d0] = *(const bf16x8*)(Qh + (size_t)(wid * 32 + r32) * DQK + d0 * 16 + hi * 8);
    const int sr = tid >> 4, sc = (tid & 15) * 8, vst0 = v_st(sr, sc), vst1 = v_st(32 + sr, sc);
    int kst[3];
#pragma unroll
    for (int i = 0; i < 3; ++i) { const int c = tid + 512 * i, key = c / 24, ch = c - key * 24; kst[i] = key * KPITCH + ch * 16; }
    bf16x8 sk[3], sv0, sv1;
#define GLOAD(t) do { const bf16_t* kp = Kh + (size_t)(t) * KVBLK * DQK; const bf16_t* vp = Vh + (size_t)(t) * KVBLK * DV; \
        _Pragma("unroll") for (int i = 0; i < 3; ++i) sk[i] = *(const bf16x8*)(kp + (size_t)(tid + 512 * i) * 8); \
        sv0 = *(const bf16x8*)(vp + (size_t)sr * DV + sc); sv1 = *(const bf16x8*)(vp + (size_t)(32 + sr) * DV + sc); } while (0)
#define SWRITE(kbf, vbf) do { _Pragma("unroll") for (int i = 0; i < 3; ++i) *(LAS bf16x8*)(lds + OFF_K + (kbf) * SHM_K + kst[i]) = sk[i]; \
        *(LAS bf16x8*)(lds + OFF_V + (vbf) * SHM_V + vst0) = sv0; *(LAS bf16x8*)(lds + OFF_V + (vbf) * SHM_V + vst1) = sv1; } while (0)
    const int qlo = qb * QB + wid * 32, qm = qlo + r32 - 4 * hi;
    const int vb0 = (int)(size_t)(lds + OFF_V) + v_rd_base(lane);
    const LAS unsigned char* kb0 = lds + OFF_K + r32 * KPITCH + hi * 16;
    float m_reg = -1e30f, l_reg = 0.f; f32x16 o[4] = {};
    GLOAD(0); SWRITE(0, 0);
#pragma unroll
    for (int d0 = 0; d0 < 12; ++d0) asm volatile("" :: "v"(qr[d0]));
    __syncthreads();
    const bool grpB = wid >= 4; bool pend = false; int vprev = 0; bf16x8 pa0, pa1, pa2, pa3;
    pa0 = pa1 = pa2 = pa3 = bf16x8{};
    int vcur = 0;
    for (int t = 0; t < NT; ++t) {
        const int cur = t & 1; const bool more = t + 1 < NT; const int vnxt = vcur == 2 ? 0 : vcur + 1;
        if (more) GLOAD(t + 1);
        if (pend) { pv_tile(o, vb0 + vprev * SHM_V, pa0, pa1, pa2, pa3); pend = false; }
        const int kbase = t * KVBLK;
        if (kbase <= qlo + 31) {
            f32x16 p0, p1; float alpha;
            qkt(p0, p1, kb0 + cur * SHM_K, qr);
            if (kbase + KVBLK - 1 > qlo) mask_tile(p0, p1, qm - kbase);
            softmax_tile(p0, p1, m_reg, alpha, l_reg, pa0, pa1, pa2, pa3);
            if (__any(alpha < 1.f)) { if (hi == 0) al_l[r32] = alpha; LDS_WAIT();
#pragma unroll
                for (int d_ = 0; d_ < 4; ++d_)
#pragma unroll
                    for (int r = 0; r < 16; ++r) o[d_][r] *= al_l[crow(r, hi)]; }
            if (grpB) { pend = true; vprev = vcur; } else pv_tile(o, vb0 + vcur * SHM_V, pa0, pa1, pa2, pa3);
        }
        if (more) SWRITE(cur ^ 1, vnxt);
        __syncthreads();
        vcur = vnxt;
    }
    if (pend) pv_tile(o, vb0 + vprev * SHM_V, pa0, pa1, pa2, pa3);
#undef GLOAD
#undef SWRITE
    if (hi == 0) li_l[r32] = l_reg; LDS_WAIT();
    const int b = bh / NH, h = bh - b * NH;
    bf16_t* Ow = MIX + ((size_t)b * SEQ + (size_t)qb * QB + wid * 32) * DM + POOLW + h * DV;
#pragma unroll
    for (int r = 0; r < 16; ++r) { const int orow = crow(r, hi); const float rl = __builtin_amdgcn_rcpf(li_l[orow]);
#pragma unroll
        for (int d0 = 0; d0 < 4; ++d0) { const float v = o[d0][r] * rl; const float vn = __shfl_xor(v, 1);
            if ((r32 & 1) == 0) *(unsigned*)(Ow + (size_t)orow * DM + d0 * 32 + r32) = cvtpk(v, vn); } }
    __syncthreads();
}
}

struct Frame {
    LAS unsigned char* lds; gu32* ctl; unsigned char* ws;
    int tid, lane, wave, vcu, G;
    float* out;
};
#define WSP(T, off) ((T*)(F.ws + (off)))
#define INP A.in

struct RowMap { int kind, base;
    __device__ __forceinline__ int operator()(int n) const {
        if (kind == 1) { if (n < 1024) return n; const int j = n - 1024; return 1024 + (j < 32 ? 2 * j : 2 * (j - 32) + 1); }
        if (kind == 2) { const int h = n / DQK, d = n - h * DQK; if (d < DNOPE) return n; const int j = d - DNOPE; return h * DQK + DNOPE + (j < 32 ? 2 * j : 2 * (j - 32) + 1); }
        if (kind == 3) { if (n < 256) return base + (n >> 7) * 256 + (n & 127); const int j = n - 256; return base + (j >> 7) * 256 + 128 + (j & 127); }
        return base + n; } };
__device__ __forceinline__ void transpose_item(const float* W, int K, int N, bf16_t* WT, const float* kscale, const RowMap rm, LAS float* scr, int item, int lane) {
    const int nblk = N / 32, kb = item / nblk, nb = item - kb * nblk, k0 = 64 * kb, n0 = 32 * nb;
    float tv[32];
#pragma unroll
    for (int i = 0; i < 32; ++i) tv[i] = W[(size_t)(k0 + 2 * i + (lane >> 5)) * N + n0 + (lane & 31)];
#pragma unroll
    for (int i = 0; i < 32; ++i) scr[(2 * i + (lane >> 5)) * 33 + (lane & 31)] = tv[i];
    LDS_WAIT(); asm volatile("" ::: "memory");
    const int c = lane & 7; float ks[8];
#pragma unroll
    for (int j = 0; j < 8; ++j) ks[j] = kscale ? kscale[k0 + 8 * c + j] : 1.f;
#pragma unroll
    for (int j = 0; j < 4; ++j) { const int n = (lane >> 3) + 8 * j; const LAS float* s = scr + (8 * c) * 33 + n;
        u32x4 o; o.x = cvtpk(s[0 * 33] * ks[0], s[1 * 33] * ks[1]); o.y = cvtpk(s[2 * 33] * ks[2], s[3 * 33] * ks[3]); o.z = cvtpk(s[4 * 33] * ks[4], s[5 * 33] * ks[5]); o.w = cvtpk(s[6 * 33] * ks[6], s[7 * 33] * ks[7]);
        *(u32x4*)(WT + (size_t)rm(n0 + n) * K + k0 + 8 * c) = o; }
    LDS_WAIT(); asm volatile("" ::: "memory");
}
__device__ __forceinline__ void phase_prologue(const Frame& F, const Args& A) {
    const float* c = INP[1]; const float* w_mod = INP[3]; const float* b_mod = INP[4];
    float* mod = WSP(float, WS_MOD);
    if (F.vcu < 96) {
        LAS float* cact = (LAS float*)F.lds; LAS float* red = (LAS float*)(F.lds + 32768);
        for (int i = F.tid; i < NB * DM; i += NTHR) { const float v = c[i]; cact[i] = v / (1.f + expf(-v)); }
        __syncthreads();
        for (int cg = F.vcu; cg < 96; cg += F.G) {
            float acc[NB];
#pragma unroll
            for (int b = 0; b < NB; ++b) acc[b] = 0.f;
            const float* wp = w_mod + (size_t)(F.wave * 128) * (NMOD * DM) + cg * 64 + F.lane;
#pragma unroll 16
            for (int k = 0; k < 128; ++k) { const float wv = wp[(size_t)k * (NMOD * DM)];
#pragma unroll
                for (int b = 0; b < NB; ++b) acc[b] += cact[b * DM + F.wave * 128 + k] * wv; }
#pragma unroll
            for (int b = 0; b < NB; ++b) red[(F.wave * NB + b) * 64 + F.lane] = acc[b];
            __syncthreads();
            if (F.wave == 0) {
#pragma unroll
                for (int b = 0; b < NB; ++b) { float s = 0.f;
#pragma unroll
                    for (int w = 0; w < NWAVES; ++w) s += red[(w * NB + b) * 64 + F.lane];
                    mod[b * (NMOD * DM) + cg * 64 + F.lane] = s + b_mod[cg * 64 + F.lane]; } }
            __syncthreads();
        }
    }
    __syncthreads();
    LAS float* scr = (LAS float*)(F.lds + F.wave * 16384);
    const int gw = F.vcu * NWAVES + F.wave, NGW = F.G * NWAVES;
    constexpr int I_IN = (DM / 64) * (INW / 32), I_UQ = (QLORA / 64) * (UQW / 32), I_UKV = (KVLORA / 64) * (UKVW / 32), I_O = (DM / 64) * (DM / 32);
    constexpr int I_GU1 = (DM / 64) * (2 * DEXP / 32), I_D1 = (DEXP / 64) * (DM / 32);
    constexpr int NITEMS = I_IN + I_UQ + I_UKV + I_O + NEXP * I_GU1 + NEXP * I_D1;
    for (int it = gw; it < NITEMS; it += NGW) {
        int r = it;
        if (r < I_IN) { transpose_item(INP[6], DM, INW, WSP(bf16_t, WS_WIN), nullptr, RowMap{1, 0}, scr, r, F.lane); continue; } r -= I_IN;
        if (r < I_UQ) { transpose_item(INP[10], QLORA, UQW, WSP(bf16_t, WS_WUQ), INP[9], RowMap{2, 0}, scr, r, F.lane); continue; } r -= I_UQ;
        if (r < I_UKV) { transpose_item(INP[12], KVLORA, UKVW, WSP(bf16_t, WS_WUKV), INP[11], RowMap{0, 0}, scr, r, F.lane); continue; } r -= I_UKV;
        if (r < I_O) { transpose_item(INP[13], DM, DM, WSP(bf16_t, WS_WO), nullptr, RowMap{0, 0}, scr, r, F.lane); continue; } r -= I_O;
        if (r < NEXP * I_GU1) { const int e = r / I_GU1; transpose_item(INP[19] + (size_t)e * DM * 2 * DEXP, DM, 2 * DEXP, WSP(bf16_t, WS_WGU), nullptr, RowMap{3, e * 512}, scr, r - e * I_GU1, F.lane); continue; } r -= NEXP * I_GU1;
        { const int e = r / I_D1; transpose_item(INP[20] + (size_t)e * DEXP * DM, DEXP, DM, WSP(bf16_t, WS_WD), nullptr, RowMap{0, e * DM}, scr, r - e * I_D1, F.lane); }
    }
    { float* WRo = WSP(float, WS_WR); const float* wg = INP[15]; const float* wr = INP[17];
        for (int i = F.vcu * NTHR + F.tid; i < DM * 48; i += F.G * NTHR) { const int k = i / 48, cc = i - k * 48; float v = 0.f; if (cc < 4) v = wg[k * 4 + cc]; else if (cc < 36) v = wr[k * 32 + cc - 4]; WRo[i] = v; } }
    { const int gt = F.vcu * NTHR + F.tid, NGT = F.G * NTHR; const u32x4 z = {0u, 0u, 0u, 0u};
        u32x4* p2 = (u32x4*)(WSP(bf16_t, WS_WUQ) + (size_t)UQW * QLORA); constexpr int n2 = (UQW_PAD - UQW) * QLORA / 8;
        for (int i = gt; i < n2; i += NGT) p2[i] = z; }
}

__device__ __forceinline__ void phase_h(const Frame& F, const Args& A) {
    const float* x = INP[0]; const float* g = INP[5]; const float* mod = WSP(float, WS_MOD); bf16_t* H = WSP(bf16_t, WS_H);
    for (int t = F.vcu * NWAVES + F.wave; t < NTOK / 16; t += F.G * NWAVES) {
        const int row0 = t * 16, b = row0 / SEQ; const float* md = mod + (size_t)b * (NMOD * DM);
        f32x4 gs[4], sh[4];
#pragma unroll
        for (int j = 0; j < 4; ++j) { const int col = 4 * F.lane + 256 * j; gs[j] = *(const f32x4*)(g + col) * (*(const f32x4*)(md + DM + col) + 1.f); sh[j] = *(const f32x4*)(md + col); }
#pragma unroll 4
        for (int r = 0; r < 16; ++r) { const float* xr = x + (size_t)(row0 + r) * DM; f32x4 v[4]; float s = 0.f;
#pragma unroll
            for (int j = 0; j < 4; ++j) { v[j] = *(const f32x4*)(xr + 4 * F.lane + 256 * j); s += dot4(v[j]); }
            const float rstd = 1.f / sqrtf(wave_sum(s) * (1.f / DM) + EPS);
#pragma unroll
            for (int j = 0; j < 4; ++j) { const f32x4 o = v[j] * rstd * gs[j] + sh[j]; u32x2 w; w.x = cvtpk(o[0], o[1]); w.y = cvtpk(o[2], o[3]);
                *(u32x2*)(H + (size_t)(row0 + r) * DM + 4 * F.lane + 256 * j) = w; } }
    }
}

__device__ __forceinline__ bf16x8 ld_lds16(const LAS unsigned char* p) { return *(const LAS bf16x8*)p; }
template <int G_>
__device__ __forceinline__ void pool_group(const LAS unsigned char* PT, const LAS unsigned char* WPT, int jr, int q, int l15, int spos, const float* pscale, bf16_t* mixrow0, int lane) {
    constexpr int W = 2 << G_;
    const float inv = 1.f / (float)(spos + 1 < W ? spos + 1 : W);
    bf16x8 A[2];
#pragma unroll
    for (int kk = 0; kk < 2; ++kk) { const int ch0 = G_ * 64 + kk * 32 + 8 * q; float a8[8], own[8];
#pragma unroll
        for (int e = 0; e < 8; ++e) a8[e] = 0.f;
#pragma unroll
        for (int j = 0; j < W; ++j) { const u32x4 w = __builtin_bit_cast(u32x4, ld_lds16(PT + (jr - j) * 528 + ch0 * 2));
            const float f[8] = {bf_lo(w.x), bf_hi(w.x), bf_lo(w.y), bf_hi(w.y), bf_lo(w.z), bf_hi(w.z), bf_lo(w.w), bf_hi(w.w)};
#pragma unroll
            for (int e = 0; e < 8; ++e) { a8[e] += f[e]; if (j == 0) own[e] = f[e]; } }
        u32x4 pk; pk.x = cvtpk(a8[0] * inv - own[0], a8[1] * inv - own[1]); pk.y = cvtpk(a8[2] * inv - own[2], a8[3] * inv - own[3]);
        pk.z = cvtpk(a8[4] * inv - own[4], a8[5] * inv - own[5]); pk.w = cvtpk(a8[6] * inv - own[6], a8[7] * inv - own[7]);
        A[kk] = __builtin_bit_cast(bf16x8, pk); }
#pragma unroll
    for (int nt = 0; nt < 4; ++nt) { f32x4 acc = {0.f, 0.f, 0.f, 0.f};
#pragma unroll
        for (int kk = 0; kk < 2; ++kk) { const bf16x8 B = ld_lds16(WPT + (G_ * 64 + nt * 16 + l15) * 144 + (kk * 32 + 8 * q) * 2);
            acc = __builtin_amdgcn_mfma_f32_16x16x32_bf16(A[kk], B, acc, 0, 0, 0); }
        const int col = G_ * 64 + nt * 16 + l15; const float ps = pscale[col];
#pragma unroll
        for (int r = 0; r < 4; ++r) { const float v = acc[r] * ps; const float vn = __shfl_xor(v, 1);
            if ((lane & 1) == 0) *(unsigned*)(mixrow0 + (size_t)(4 * q + r) * DM + col) = cvtpk(v, vn); } }
}
__device__ __forceinline__ void phase_pool(const Frame& F, const Args& A) {
    const bf16_t* P = WSP(bf16_t, WS_P); const float* w_pool = INP[7]; const float* pscale = INP[8]; bf16_t* MIX = WSP(bf16_t, WS_MIX);
    LAS unsigned char* PT = F.lds; LAS unsigned char* WPT = F.lds + 76800;
    for (int i = F.tid; i < 4 * 64 * 64; i += NTHR) { const int g = i >> 12, cc = (i >> 6) & 63, d = i & 63;
        *(LAS bf16_t*)(WPT + (g * 64 + d) * 144 + cc * 2) = (bf16_t)(cvtpk(w_pool[i], 0.f) & 0xffffu); }
    for (int tb = F.vcu; tb < NTOK / 128; tb += F.G) {
        const int row0 = tb * 128, b = row0 / SEQ, s0 = row0 - b * SEQ;
        __syncthreads();
        for (int i = F.tid; i < 143 * 32; i += NTHR) { const int j = i >> 5, ch = i & 31, s = s0 - 15 + j;
            u32x4 v = {0u, 0u, 0u, 0u}; if (s >= 0) v = *(const u32x4*)(P + ((size_t)b * SEQ + s) * POOLW + ch * 8);
            *(LAS u32x4*)(PT + j * 528 + ch * 16) = v; }
        __syncthreads();
        const int l15 = F.lane & 15, q = F.lane >> 4, tok = 16 * F.wave + l15, jr = tok + 15, spos = s0 + tok;
        bf16_t* mixrow0 = MIX + (size_t)(row0 + 16 * F.wave) * DM;
        pool_group<0>(PT, WPT, jr, q, l15, spos, pscale, mixrow0, F.lane);
        pool_group<1>(PT, WPT, jr, q, l15, spos, pscale, mixrow0, F.lane);
        pool_group<2>(PT, WPT, jr, q, l15, spos, pscale, mixrow0, F.lane);
        pool_group<3>(PT, WPT, jr, q, l15, spos, pscale, mixrow0, F.lane);
    }
    __syncthreads();
}


__device__ __forceinline__ void phase_krope(const Frame& F, const Args& A) {
    const bf16_t* H = WSP(bf16_t, WS_H); const bf16_t* Wk = WSP(bf16_t, WS_WIN) + (size_t)1024 * DM; bf16_t* Kb = WSP(bf16_t, WS_K); const int* pos = (const int*)INP[2];
    LAS unsigned char* WL = F.lds;
    __syncthreads();
    for (int i = F.tid; i < 64 * 128; i += NTHR) { const int n = i >> 7, ch = i & 127; *(LAS u32x4*)(WL + n * 2064 + ch * 16) = *(const u32x4*)(Wk + (size_t)n * DM + ch * 8); }
    __syncthreads();
    const int l15 = F.lane & 15, q = F.lane >> 4;
    for (int tb = F.vcu; tb < NTOK / 128; tb += F.G) {
        const int row0 = tb * 128 + 16 * F.wave; const bf16_t* hr = H + (size_t)(row0 + l15) * DM + 8 * q;
        f32x4 acc[4] = {{0.f, 0.f, 0.f, 0.f}, {0.f, 0.f, 0.f, 0.f}, {0.f, 0.f, 0.f, 0.f}, {0.f, 0.f, 0.f, 0.f}};
#pragma unroll 2
        for (int k8 = 0; k8 < 4; ++k8) { bf16x8 av[8];
#pragma unroll
            for (int j = 0; j < 8; ++j) av[j] = *(const bf16x8*)(hr + (k8 * 8 + j) * 32);
#pragma unroll
            for (int j = 0; j < 8; ++j)
#pragma unroll
                for (int nt = 0; nt < 4; ++nt) { const bf16x8 bv = *(const LAS bf16x8*)(WL + (nt * 16 + l15) * 2064 + ((k8 * 8 + j) * 32 + 8 * q) * 2);
                    acc[nt] = __builtin_amdgcn_mfma_f32_16x16x32_bf16(av[j], bv, acc[nt], 0, 0, 0); } }
#pragma unroll
        for (int r = 0; r < 4; ++r) { const int row = row0 + 4 * q + r, b = row / SEQ, s = row - b * SEQ; const int p = pos[row];
#pragma unroll
            for (int nt = 0; nt < 4; ++nt) { const int c = nt * 16 + l15; float cs, sn; rope_cs(p, c >> 1, cs, sn);
                const float own = acc[nt][r], oth = __shfl_xor(own, 1); const float o = (l15 & 1) ? own * cs + oth * sn : own * cs - oth * sn; const float on = __shfl_xor(o, 1);
                if ((l15 & 1) == 0) { const unsigned w = cvtpk(o, on);
#pragma unroll
                    for (int h = 0; h < NH; ++h) *(unsigned*)(Kb + ((size_t)(b * NH + h) * SEQ + s) * DQK + DNOPE + c) = w; } } }
    }
    __syncthreads();
}

__device__ __forceinline__ void phase_attn(const Frame& F, const Args& A) {
    const bf16_t* Q = WSP(bf16_t, WS_Q); const bf16_t* K = WSP(bf16_t, WS_K); const bf16_t* V = WSP(bf16_t, WS_V); bf16_t* MIX = WSP(bf16_t, WS_MIX);
    volatile LAS int* mbox = (volatile LAS int*)(F.lds + LX_MBOX);
    for (;;) {
        if (F.tid == 0) mbox[0] = (int)__hip_atomic_fetch_add((unsigned*)(F.ctl + CW_ATTNQ), 1u, __ATOMIC_RELAXED, __HIP_MEMORY_SCOPE_AGENT);
        __syncthreads();
        const int u = mbox[0];
        __syncthreads();
        if (u >= att::NUNIT) break;
        const int qb = 15 - u / (NB * NH), bh = u % (NB * NH);
        att::attn_unit(bh, qb, Q, K, V, MIX, F.lds);
    }
}

__device__ __forceinline__ void phase_route(const Frame& F, const Args& A) {
    const float* X1 = F.out; const float* ssq = WSP(float, WS_SSQX); const float* mod = WSP(float, WS_MOD); const float* gffn = INP[14];
    const float* b_group = INP[16]; const float* b_router = INP[18]; const float* WR = WSP(float, WS_WR);
    bf16_t* H2 = WSP(bf16_t, WS_H); int* ltok = WSP(int, WS_LTOK); unsigned* tinfo = WSP(unsigned, WS_TINFO); float* tw = WSP(float, WS_TW);
    LAS float* GS = (LAS float*)(F.lds + 53248); LAS float* SH = (LAS float*)(F.lds + 57344);
    LAS float* LOG = (LAS float*)(F.lds + 61440) + F.wave * (16 * 48);
    LAS int* LCNT = (LAS int*)(F.lds + 86016); LAS int* LBASE = (LAS int*)(F.lds + 86144);
    const int l15 = F.lane & 15, q = F.lane >> 4;
    int wsrc[3], wdst[3];
#pragma unroll
    for (int j = 0; j < 3; ++j) { const int idx = F.tid + NTHR * j, kl = idx / 12, c4 = idx - kl * 12; wsrc[j] = kl * 48 + c4 * 4; wdst[j] = kl * 208 + c4 * 16; }
    for (int tb = F.vcu; tb < NTOK / 128; tb += F.G) {
        const int row0 = tb * 128, b = row0 / SEQ; const float* md = mod + (size_t)b * (NMOD * DM);
        __syncthreads();
        for (int k = F.tid; k < DM; k += NTHR) { GS[k] = gffn[k] * (1.f + md[4 * DM + k]); SH[k] = md[3 * DM + k]; }
        if (F.tid < NEXP) LCNT[F.tid] = 0;
        const int row = row0 + 16 * F.wave + l15;
        float rstd; { const float* sp = ssq + (size_t)row * 16; const f32x4 a = *(const f32x4*)sp, b4 = *(const f32x4*)(sp + 4), c4 = *(const f32x4*)(sp + 8), d4 = *(const f32x4*)(sp + 12);
            const float ss = (((a[0] + a[1]) + (a[2] + a[3])) + ((b4[0] + b4[1]) + (b4[2] + b4[3]))) + (((c4[0] + c4[1]) + (c4[2] + c4[3])) + ((d4[0] + d4[1]) + (d4[2] + d4[3])));
            rstd = 1.f / sqrtf(ss * (1.f / DM) + EPS); }
        const float* xr = X1 + (size_t)row * DM + 4 * q;
        f32x4 wreg[3], xreg[8], xnxt[8];
#pragma unroll
        for (int j = 0; j < 3; ++j) wreg[j] = *(const f32x4*)(WR + wsrc[j]);
#pragma unroll
        for (int i = 0; i < 8; ++i) xreg[i] = *(const f32x4*)(xr + 16 * i);
#pragma unroll
        for (int j = 0; j < 3; ++j) *(LAS f32x4*)(F.lds + wdst[j]) = wreg[j];
        __syncthreads();
        f32x4 acc[3] = {{0.f, 0.f, 0.f, 0.f}, {0.f, 0.f, 0.f, 0.f}, {0.f, 0.f, 0.f, 0.f}};
#pragma unroll
        for (int c = 0; c < 8; ++c) {
            const LAS float* WL = (const LAS float*)(F.lds + (c & 1) * 26624);
            if (c < 7) {
#pragma unroll
                for (int j = 0; j < 3; ++j) wreg[j] = *(const f32x4*)(WR + (c + 1) * (128 * 48) + wsrc[j]);
#pragma unroll
                for (int i = 0; i < 8; ++i) xnxt[i] = *(const f32x4*)(xr + (c + 1) * 128 + 16 * i); }
#pragma unroll
            for (int i = 0; i < 8; ++i) { const int kk = c * 128 + 16 * i + 4 * q;
                const f32x4 gv = *(const LAS f32x4*)(GS + kk), sv = *(const LAS f32x4*)(SH + kk);
                const f32x4 hv = xreg[i] * rstd * gv + sv;
                u32x2 w; w.x = cvtpk(hv[0], hv[1]); w.y = cvtpk(hv[2], hv[3]); *(u32x2*)(H2 + (size_t)row * DM + kk) = w;
#pragma unroll
                for (int e = 0; e < 4; ++e) { const LAS float* wl = WL + (16 * i + 4 * q + e) * 52 + l15;
#pragma unroll
                    for (int t = 0; t < 3; ++t) acc[t] = __builtin_amdgcn_mfma_f32_16x16x4f32(hv[e], wl[t * 16], acc[t], 0, 0, 0); } }
            if (c < 7) {
#pragma unroll
                for (int j = 0; j < 3; ++j) *(LAS f32x4*)(F.lds + ((c + 1) & 1) * 26624 + wdst[j]) = wreg[j];
#pragma unroll
                for (int i = 0; i < 8; ++i) xreg[i] = xnxt[i]; }
            __syncthreads();
        }
#pragma unroll
        for (int t = 0; t < 3; ++t)
#pragma unroll
            for (int r = 0; r < 4; ++r) LOG[(4 * q + r) * 48 + t * 16 + l15] = acc[t][r];
        LDS_WAIT(); asm volatile("" ::: "memory");
        int e_sel[2] = {0, 0}, rank[2] = {0, 0}; float wsel[2] = {0.f, 0.f};
        if (F.lane < 16) {
            const LAS float* L = LOG + F.lane * 48;
            float gl[4], ge[4], ein[8], eb[8];
#pragma unroll
            for (int j = 0; j < 4; ++j) gl[j] = L[j];
            const float gmx = fmaxf(fmaxf(gl[0], gl[1]), fmaxf(gl[2], gl[3])); float gsum = 0.f;
#pragma unroll
            for (int j = 0; j < 4; ++j) { ge[j] = expf(gl[j] - gmx); gsum += ge[j]; }
            int gsel = 0; float gbest = gl[0] + b_group[0], gesel = ge[0];
#pragma unroll
            for (int j = 1; j < 4; ++j) { const float v = gl[j] + b_group[j]; if (v > gbest) { gbest = v; gsel = j; gesel = ge[j]; } }
            const float gp = gesel / gsum;
#pragma unroll
            for (int j = 0; j < 8; ++j) { ein[j] = L[4 + gsel * 8 + j]; eb[j] = ein[j] + b_router[gsel * 8 + j]; }
            float b1 = eb[0], e1 = ein[0]; int i1 = 0;
#pragma unroll
            for (int j = 1; j < 8; ++j) if (eb[j] > b1) { b1 = eb[j]; e1 = ein[j]; i1 = j; }
            float b2 = -__builtin_inff(), e2 = 0.f; int i2 = 0;
#pragma unroll
            for (int j = 0; j < 8; ++j) if (j != i1 && eb[j] > b2) { b2 = eb[j]; e2 = ein[j]; i2 = j; }
            const float mx = fmaxf(e1, e2), x1 = expf(e1 - mx), x2 = expf(e2 - mx), den = x1 + x2;
            wsel[0] = gp * (x1 / den); wsel[1] = gp * (x2 / den);
            e_sel[0] = gsel * 8 + i1; e_sel[1] = gsel * 8 + i2;
            rank[0] = __hip_atomic_fetch_add(LCNT + e_sel[0], 1, __ATOMIC_RELAXED, __HIP_MEMORY_SCOPE_WORKGROUP);
            rank[1] = __hip_atomic_fetch_add(LCNT + e_sel[1], 1, __ATOMIC_RELAXED, __HIP_MEMORY_SCOPE_WORKGROUP);
        }
        __syncthreads();
        if (F.tid < NEXP) { const int n = LCNT[F.tid]; LBASE[F.tid] = n > 0 ? (int)__hip_atomic_fetch_add((unsigned*)(F.ctl + CW_ECNT + 64 * F.tid), (unsigned)n, __ATOMIC_RELAXED, __HIP_MEMORY_SCOPE_AGENT) : 0; }
        __syncthreads();
        if (F.lane < 16) { const int tok = row0 + 16 * F.wave + F.lane;
#pragma unroll
            for (int k = 0; k < 2; ++k) { const int e = e_sel[k], p = LBASE[e] + rank[k]; ltok[(size_t)e * NTOK + p] = tok; tinfo[tok * 2 + k] = (unsigned)e | ((unsigned)p << 8); tw[tok * 2 + k] = wsel[k]; } }
    }
    __syncthreads();
}

__device__ __forceinline__ int moe_tables(const Frame& F, const Args& A) {
    LAS int* ECNT = (LAS int*)(F.lds + LX_ECNT); LAS int* TBASE = (LAS int*)(F.lds + LX_TBASE); LAS int* TILEE = (LAS int*)(F.lds + LX_TILEE);
    __syncthreads();
    if (F.tid < NEXP) ECNT[F.tid] = (int)__hip_atomic_load((unsigned*)(F.ctl + CW_ECNT + 64 * F.tid), __ATOMIC_RELAXED, __HIP_MEMORY_SCOPE_AGENT);
    __syncthreads();
    if (F.tid == 0) { int s = 0; for (int e = 0; e < NEXP; ++e) { TBASE[e] = s; s += (ECNT[e] + 255) >> 8; } TBASE[NEXP] = s; }
    __syncthreads();
    const int nrt = TBASE[NEXP];
    for (int rt = F.tid; rt < nrt; rt += NTHR) { int e = 0; for (int j = 1; j < NEXP; ++j) if (TBASE[j] <= rt) e = j; TILEE[rt] = e; }
    __syncthreads();
    return nrt;
}

__device__ __forceinline__ void phase_final(const Frame& F, const Args& A) {
    float* X = F.out; const float* mod = WSP(float, WS_MOD); const float* fg = INP[21]; const bf16_t* YS = WSP(bf16_t, WS_YS);
    const unsigned* tinfo = WSP(unsigned, WS_TINFO); const float* tw = WSP(float, WS_TW);
    (void)moe_tables(F, A);
    const LAS int* TBASE = (const LAS int*)(F.lds + LX_TBASE);
    for (int t = F.vcu * NWAVES + F.wave; t < NTOK / 16; t += F.G * NWAVES) {
        const int row0 = t * 16, b = row0 / SEQ; const float* md = mod + (size_t)b * (NMOD * DM);
        f32x4 gf[4], fgv[4];
#pragma unroll
        for (int j = 0; j < 4; ++j) { const int col = 4 * F.lane + 256 * j; gf[j] = *(const f32x4*)(md + 5 * DM + col); fgv[j] = *(const f32x4*)(fg + col); }
        unsigned ti = 0u; float twv = 0.f;
        if (F.lane < 32) { ti = tinfo[row0 * 2 + F.lane]; twv = tw[row0 * 2 + F.lane]; }
        const int srow = TBASE[ti & 255u] * 256 + (int)(ti >> 8);
#pragma unroll
        for (int rg = 0; rg < 16; rg += 4) {
            f32x4 xv[4][4]; u32x2 ya[4][4], yc[4][4]; float w0[4], w1[4];
#pragma unroll
            for (int rr = 0; rr < 4; ++rr) { const int r = rg + rr, row = row0 + r;
                const size_t r0 = (size_t)__builtin_amdgcn_readlane(srow, 2 * r), r1 = (size_t)__builtin_amdgcn_readlane(srow, 2 * r + 1);
                w0[rr] = __uint_as_float(__builtin_amdgcn_readlane(__float_as_uint(twv), 2 * r)); w1[rr] = __uint_as_float(__builtin_amdgcn_readlane(__float_as_uint(twv), 2 * r + 1));
#pragma unroll
                for (int j = 0; j < 4; ++j) { const int col = 4 * F.lane + 256 * j; xv[rr][j] = *(const f32x4*)(X + (size_t)row * DM + col);
                    ya[rr][j] = *(const u32x2*)(YS + r0 * DM + col); yc[rr][j] = *(const u32x2*)(YS + r1 * DM + col); } }
#pragma unroll
            for (int rr = 0; rr < 4; ++rr) { const int row = row0 + rg + rr; f32x4 v[4]; float s = 0.f;
#pragma unroll
                for (int j = 0; j < 4; ++j) { const u32x2 a = ya[rr][j], c = yc[rr][j]; f32x4 y;
                    y[0] = w0[rr] * bf_lo(a.x) + w1[rr] * bf_lo(c.x); y[1] = w0[rr] * bf_hi(a.x) + w1[rr] * bf_hi(c.x); y[2] = w0[rr] * bf_lo(a.y) + w1[rr] * bf_lo(c.y); y[3] = w0[rr] * bf_hi(a.y) + w1[rr] * bf_hi(c.y);
                    v[j] = xv[rr][j] + gf[j] * y; s += dot4(v[j]); }
                const float rstd = 1.f / sqrtf(wave_sum(s) * (1.f / DM) + EPS);
#pragma unroll
                for (int j = 0; j < 4; ++j) *(f32x4*)(X + (size_t)row * DM + 4 * F.lane + 256 * j) = v[j] * rstd * fgv[j]; }
        }
    }
}

#ifndef MK_N_LAUNCHES
#define MK_N_LAUNCHES 1
#endif
constexpr int NPH = 10;

__global__ void __launch_bounds__(NTHR, 2) fwd_kernel(Args A) {
    extern __shared__ __attribute__((aligned(16))) unsigned char lds_raw[];
    Frame F;
    F.lds = (LAS unsigned char*)lds_raw; F.ws = A.ws; F.ctl = (gu32*)(A.ws + WS_CTL);
    F.tid = threadIdx.x; F.lane = F.tid & 63; F.wave = __builtin_amdgcn_readfirstlane(F.tid >> 6);
    F.G = gridDim.x; { const int bx = blockIdx.x; F.vcu = (F.G % 8 == 0) ? (bx % 8) * (F.G / 8) + bx / 8 : bx; }
    F.out = A.out;
    for (int u = F.tid; u < (LDS_BYTES - LX_BASE) / 4; u += NTHR) ((LAS unsigned*)(F.lds + LX_BASE))[u] = 0u;
    __syncthreads();
    const int lo = A.ph_lo, hi = A.ph_hi;
    XcdBarrier bar; bar.bar = (unsigned*)(F.ctl + CW_BAR); bar.x = 0; bar.st = nullptr;
    if (hi - lo > 1) bar = xcd_barrier_post((unsigned*)(F.ctl + CW_BAR), (volatile LAS unsigned*)(F.lds + LX_MISC));
#ifndef PH_MASK
#define PH_MASK 0x3ff
#endif
#define IN(k) (((PH_MASK >> (k)) & 1) && lo <= (k) && (k) < hi)
#define SEAM(k) do { if (IN(k) && IN((k) + 1)) xcd_barrier(bar); } while (0)

    if (IN(0)) { phase_prologue(F, A); } SEAM(0);
    if (IN(1)) { phase_h(F, A); } SEAM(1);
    if (IN(2)) {
        pg8::Gemm g{WSP(bf16_t, WS_H), WSP(bf16_t, WS_WIN), NTOK, 1024, DM}; DenseOrder S{4, (NTOK / 256) * 4, F.G, F.vcu};
        EpiU E{WSP(bf16_t, WS_P), WSP(bf16_t, WS_CQ), WSP(bf16_t, WS_CKV), WSP(float, WS_SSQQ), WSP(float, WS_SSQKV)};
        pg8::gemm_phase<EpiU, DenseOrder, true, true, false>(F.lds, g, S, E);
    } SEAM(2);
    if (IN(3)) {
        { pg8::Gemm g{WSP(bf16_t, WS_CQ), WSP(bf16_t, WS_WUQ), NTOK, UQW_PAD, QLORA}; DenseOrder S{UQW_PAD / 256, (NTOK / 256) * (UQW_PAD / 256), F.G, F.vcu};
          EpiQ E{WSP(bf16_t, WS_Q), WSP(float, WS_SSQQ), (const int*)A.in[2]};
          pg8::gemm_phase<EpiQ, DenseOrder, true, true, false>(F.lds, g, S, E); }
        { pg8::Gemm g{WSP(bf16_t, WS_CKV), WSP(bf16_t, WS_WUKV), NTOK, UKVW, KVLORA}; KvOrder S{F.G, F.vcu};
          EpiKV E{WSP(bf16_t, WS_K), WSP(bf16_t, WS_V), WSP(float, WS_SSQKV)};
          pg8::gemm_phase<EpiKV, KvOrder, true, true, false>(F.lds, g, S, E); }
        phase_pool(F, A);
        phase_krope(F, A);
    } SEAM(3);
    if (IN(4)) { phase_attn(F, A); } SEAM(4);
    if (IN(5)) {
        pg8::Gemm g{WSP(bf16_t, WS_MIX), WSP(bf16_t, WS_WO), NTOK, DM, DM}; DenseOrder S{DM / 256, (NTOK / 256) * (DM / 256), F.G, F.vcu};
        EpiO E{A.in[0], F.out, WSP(float, WS_MOD) + 2 * DM, WSP(float, WS_SSQX)};
        pg8::gemm_phase<EpiO, DenseOrder, true, true, false>(F.lds, g, S, E);
    } SEAM(5);
    if (IN(6)) { phase_route(F, A); } SEAM(6);
    if (IN(7)) {
        const int nrt = moe_tables(F, A);
        const LAS int* ECNT = (const LAS int*)(F.lds + LX_ECNT); const LAS int* TBASE = (const LAS int*)(F.lds + LX_TBASE); const LAS int* TILEE = (const LAS int*)(F.lds + LX_TILEE);
        LAS unsigned* GTAB = (LAS unsigned*)(F.lds + LX_GTAB); const int* ltok = WSP(int, WS_LTOK);
        const int total = nrt * 2;
        for (int i = 0; i < 4; ++i) { const int L = i * F.G + F.vcu;
            if (L < total && F.tid < 256) { const int rt = L >> 1, e = TILEE[rt], p = 256 * (rt - TBASE[e]) + F.tid;
                const int tok = p < ECNT[e] ? ltok[(size_t)e * NTOK + p] : 0; GTAB[i * 256 + F.tid] = (unsigned)tok * (unsigned)(DM * 2); } }
        __syncthreads();
        pg8::Gemm g{WSP(bf16_t, WS_H), WSP(bf16_t, WS_WGU), NTOK, NEXP * 512, DM}; MoeOrder S{2, total, F.G, F.vcu, TILEE, GTAB};
        EpiGU E{WSP(bf16_t, WS_ACT)};
        pg8::gemm_phase<EpiGU, MoeOrder, true, true, true>(F.lds, g, S, E);
    } SEAM(7);
    if (IN(8)) {
        const int nrt = moe_tables(F, A);
        const LAS int* TILEE = (const LAS int*)(F.lds + LX_TILEE);
        pg8::Gemm g{WSP(bf16_t, WS_ACT), WSP(bf16_t, WS_WD), MAXRT * 256, NEXP * DM, DEXP}; MoeOrder S{4, nrt * 4, F.G, F.vcu, TILEE, nullptr};
        EpiDown E{WSP(bf16_t, WS_YS)};
        pg8::gemm_phase<EpiDown, MoeOrder, true, true, false>(F.lds, g, S, E);
    } SEAM(8);
    if (IN(9)) { phase_final(F, A); }
#undef IN
#undef SEAM
}

extern "C" void kernel_launch(void* const* d_in, const int* in_sizes, int n_in, void* d_out, int out_size, void* d_ws, size_t ws_size, hipStream_t stream) {
    static int grid = 0;
    if (grid == 0) {
        if (n_in != 22 || in_sizes[0] != NTOK * DM || out_size != NTOK * DM || ws_size < WS_END) {
            fprintf(stderr, "kernel_launch: built for 22 inputs, x/out of %d floats, >= %zu bytes of workspace; got n_in %d, in0 %d, out %d, ws %zu; nothing launched\n", NTOK * DM, (size_t)WS_END, n_in, n_in > 0 ? in_sizes[0] : -1, out_size, ws_size);
            grid = -1; return; }
        int dev = 0, cus = 0, per_cu = 0;
        if (hipGetDevice(&dev) != hipSuccess || hipDeviceGetAttribute(&cus, hipDeviceAttributeMultiprocessorCount, dev) != hipSuccess) { fprintf(stderr, "kernel_launch: device query failed\n"); grid = -1; return; }
        if (hipFuncSetAttribute((const void*)fwd_kernel, hipFuncAttributeMaxDynamicSharedMemorySize, LDS_BYTES) != hipSuccess) { fprintf(stderr, "kernel_launch: hipFuncSetAttribute failed\n"); grid = -1; return; }
        if (hipOccupancyMaxActiveBlocksPerMultiprocessor(&per_cu, (const void*)fwd_kernel, NTHR, LDS_BYTES) != hipSuccess || per_cu < 1)
            fprintf(stderr, "kernel_launch: note: occupancy query reports %d workgroups per CU\n", per_cu);
        (void)hipGetLastError();
        grid = cus;
    }
    if (grid < 0) return;
    if (hipMemsetAsync((char*)d_ws + WS_CTL, 0, CTL_ZERO_BYTES, stream) != hipSuccess) { fprintf(stderr, "kernel_launch: hipMemsetAsync failed\n"); return; }
    Args a{};
    for (int i = 0; i < 22; ++i) a.in[i] = (const float*)d_in[i];
    a.out = (float*)d_out; a.ws = (unsigned char*)d_ws;
    if (MK_N_LAUNCHES == 1) { a.ph_lo = 0; a.ph_hi = NPH; hipLaunchKernelGGL(fwd_kernel, dim3(grid), dim3(NTHR), LDS_BYTES, stream, a); }
    else for (int p = 0; p < NPH; ++p) { a.ph_lo = p; a.ph_hi = p + 1; hipLaunchKernelGGL(fwd_kernel, dim3(grid), dim3(NTHR), LDS_BYTES, stream, a); }
    const hipError_t le = hipPeekAtLastError();
    if (le != hipSuccess) fprintf(stderr, "kernel_launch: launch failed: %s\n", hipGetErrorName(le));
}
```

```cpp
#include <hip/hip_runtime.h>
#include <cstdio>
#include <cstdint>

#define LAS __attribute__((address_space(3)))
#define GAS __attribute__((address_space(1)))
typedef unsigned short bf16_t;
typedef short bf16x8 __attribute__((ext_vector_type(8)));
typedef short s16x4 __attribute__((ext_vector_type(4)));
typedef float f32x2 __attribute__((ext_vector_type(2)));
typedef float f32x4 __attribute__((ext_vector_type(4)));
typedef float f32x16 __attribute__((ext_vector_type(16)));
typedef unsigned u32x2 __attribute__((ext_vector_type(2)));
typedef unsigned u32x4 __attribute__((ext_vector_type(4)));
typedef __bf16 bf16x2_t __attribute__((ext_vector_type(2)));
typedef GAS unsigned gu32;

constexpr int NB = 8, SEQ = 4096, DM = 1024, NTOK = NB * SEQ;
constexpr int NH = 6, DQK = 192, DNOPE = 128, DROPE = 64, DV = 128;
constexpr int QLORA = 512, KVLORA = 256, POOLW = 256;
constexpr int INW = 1088, INW_PAD = 1280, UQW = 1152, UQW_PAD = 1280, UKVW = 1536;
constexpr int NEXP = 32, DEXP = 256, NMOD = 6;
constexpr float EPS = 1e-6f;
constexpr int MAXRT = 288;
constexpr int NWAVES = 8, NTHR = 512;

constexpr size_t MiB = 1u << 20;
constexpr size_t WS_CTL = 0, CTL_ZERO_BYTES = 65536;
constexpr size_t WS_MOD = 1 * MiB;
constexpr size_t WS_WIN = 2 * MiB;
constexpr size_t WS_WUQ = 5 * MiB;
constexpr size_t WS_WUKV = 7 * MiB;
constexpr size_t WS_WO = 8 * MiB;
constexpr size_t WS_WGU = 10 * MiB;
constexpr size_t WS_WD = 42 * MiB;
constexpr size_t WS_WR = 1 * MiB + 512 * 1024;
constexpr size_t WS_SSQQ = 58 * MiB;
constexpr size_t WS_SSQKV = 59 * MiB;
constexpr size_t WS_SSQX = 60 * MiB;
constexpr size_t WS_LTOK = 62 * MiB;
constexpr size_t WS_TINFO = 66 * MiB;
constexpr size_t WS_TW = 66 * MiB + 512 * 1024;
constexpr size_t WS_H = 68 * MiB;
constexpr size_t WS_P = 132 * MiB;
constexpr size_t WS_CQ = 148 * MiB;
constexpr size_t WS_CKV = 180 * MiB;
constexpr size_t WS_ACT = 132 * MiB;
constexpr size_t WS_Q = 196 * MiB;
constexpr size_t WS_K = 268 * MiB;
constexpr size_t WS_V = 340 * MiB;
constexpr size_t WS_X1B = 196 * MiB;
constexpr size_t WS_YS = 268 * MiB;
constexpr size_t WS_MIX = 388 * MiB;
constexpr size_t WS_END = 452 * MiB;
static_assert(WS_ACT + (size_t)MAXRT * 256 * 256 * 2 <= WS_CKV && WS_YS + (size_t)MAXRT * 256 * 1024 * 2 <= WS_END && WS_X1B + (size_t)NTOK * DM * 2 <= WS_K, "overlays");
constexpr int CW_BAR = 4096;
constexpr int CW_ATTNQ = 8192;
constexpr int CW_ECNT = 8448;
static_assert((CW_ECNT + 64 * NEXP) * 4 <= (int)CTL_ZERO_BYTES, "CTL words inside the memset region");

constexpr int RING_BYTES = 131072;
constexpr int LX_BASE = RING_BYTES + 2048;
constexpr int LX_MISC = LX_BASE;
constexpr int LX_MBOX = LX_BASE + 64;
constexpr int LX_ECNT = LX_BASE + 256;
constexpr int LX_TBASE = LX_ECNT + 128;
constexpr int LX_TILEE = LX_TBASE + 256;
constexpr int LX_GTAB = LX_BASE + 4096;
constexpr int LDS_BYTES = RING_BYTES + 16384;
static_assert(LX_TILEE + MAXRT * 4 <= LX_GTAB && LX_GTAB + 4 * 1024 <= LDS_BYTES, "LDS map");

#define LDS_WAIT() asm volatile("s_waitcnt lgkmcnt(0)" ::: "memory")
#define VM_WAIT() asm volatile("s_waitcnt vmcnt(0)" ::: "memory")
#define SBAR() __builtin_amdgcn_sched_barrier(0)
__device__ __forceinline__ unsigned cvtpk(float lo, float hi) { f32x2 v = {lo, hi}; bf16x2_t b = __builtin_convertvector(v, bf16x2_t); return __builtin_bit_cast(unsigned, b); }
__device__ __forceinline__ float bf_lo(unsigned w) { return __uint_as_float(w << 16); }
__device__ __forceinline__ float bf_hi(unsigned w) { return __uint_as_float(w & 0xffff0000u); }
__device__ __forceinline__ float wave_sum(float v) {
#pragma unroll
    for (int o = 1; o < 64; o <<= 1) v += __shfl_xor(v, o);
    return v;
}
__device__ __forceinline__ void rope_cs(int pos, int i, float& c, float& s) {
    const float f = __builtin_amdgcn_exp2f(-0.41524101186092f * (float)i) * 0.15915494309189535f;
    const float p = (float)pos, hi = p * f, lo = __builtin_fmaf(p, f, -hi);
    float r = hi - __builtin_rintf(hi); r += lo;
    c = __builtin_amdgcn_cosf(r); s = __builtin_amdgcn_sinf(r);
}

namespace pg8 {
#define PG8_LAS __attribute__((address_space(3)))
typedef unsigned short bf16_t;
typedef short bf16x8 __attribute__((ext_vector_type(8)));
typedef float f32x4 __attribute__((ext_vector_type(4)));
typedef unsigned u32x4 __attribute__((ext_vector_type(4)));
constexpr int BM = 256, BK = 64, HALF = 128, HTB = HALF * BK * 2  , STAGE_BYTES = 8 * HTB, NXCD = 8, WGM = 8;

__host__ __device__ __forceinline__ int lds_byte(int r, int c) { const int st = (r >> 4) * 2 + (c >> 5), rr = r & 15, cc = c & 31, ob = rr * 64 + cc * 2; return st * 1024 + (ob ^ (((ob >> 9) & 1) << 5)); }
__host__ __device__ __forceinline__ void stage_rc(int b, int& R, int& C) { const int st = b / 1024, sb = b % 1024, swz = sb ^ (((sb >> 9) & 1) << 5); R = (st >> 1) * 16 + swz / 64; C = (st & 1) * 32 + (swz % 64) / 2; }
__host__ __device__ __forceinline__ int perm32(int rho) { const int n = rho >> 4, i = rho & 15; return 8 * (i >> 2) + 4 * n + (i & 3); }

struct Unit { int pm, pn; };
struct Gemm { const bf16_t* A; const bf16_t* Bt; int M, N, K; };

template <class Epi, class Sched, bool ALIGN_EPI = false, bool SP2 = false, bool GATHER = false>
__device__ __forceinline__ void gemm_phase(PG8_LAS unsigned char* lds, const Gemm g, const Sched& S, const Epi& E) {
    const int tid = threadIdx.x, wid = __builtin_amdgcn_readfirstlane(tid >> 6), lane = tid & 63, wr = wid >> 2, wc = wid & 3, fr = lane & 15, fq = lane >> 4;
    const int K = g.K, nt = K / BK;
    unsigned voffA[2], voffB[2];
#pragma unroll
    for (int i = 0; i < 2; ++i) { int R, C; stage_rc(tid * 16 + i * 8192, R, C); const int Rb = Epi::PERM ? ((R & ~31) + perm32(R & 31)) : R;
        voffA[i] = (unsigned)(R * K + C) * 2u; voffB[i] = (unsigned)(Rb * K + C) * 2u; }
    int gR0 = 0; unsigned gCb = 0; const PG8_LAS unsigned* gtab = nullptr;
    if constexpr (GATHER) { int R, C; stage_rc(tid * 16, R, C); gR0 = R; gCb = (unsigned)C * 2u; gtab = S.gtab(); }
    const size_t kstep = (size_t)(BK * 2);
    const size_t hstep = (size_t)HALF * K * 2;
    const size_t tstep = 2 * hstep;
    const unsigned ldsw = (unsigned)wid * 1024u;
    const int aoff = lds_byte(wr * 64 + fr, fq * 8), boff = lds_byte(wc * 32 + fr, fq * 8);
#define PG8_SA(b, h) (((b) * 2 + (h)) * HTB)
#define PG8_SB(b, h) ((4 + (b) * 2 + (h)) * HTB)
#define PG8_STAGE(bufoff, gbase, voff) do { _Pragma("unroll") for (int _i = 0; _i < 2; ++_i) \
        __builtin_amdgcn_global_load_lds((const unsigned*)((const char*)(gbase) + (voff)[_i]), (PG8_LAS unsigned*)(lds + (bufoff) + ldsw + _i * 8192), 16, 0, 0); } while (0)
#define PG8_STAGE_A(bufoff, ptr, us, half, kt) do { if constexpr (GATHER) { _Pragma("unroll") for (int _i = 0; _i < 2; ++_i) { const unsigned _o = gtab[(us) * 256 + (half) * 128 + gR0 + 64 * _i]; \
        __builtin_amdgcn_global_load_lds((const unsigned*)((const char*)g.A + _o + gCb + (size_t)(kt) * kstep), (PG8_LAS unsigned*)(lds + (bufoff) + ldsw + _i * 8192), 16, 0, 0); } } \
        else { PG8_STAGE(bufoff, ptr, voffA); } } while (0)
#define PG8_LDA(dst, b, h) do { _Pragma("unroll") for (int m = 0; m < 4; ++m) _Pragma("unroll") for (int k = 0; k < 2; ++k) dst[m][k] = *(const PG8_LAS bf16x8*)(lds + PG8_SA(b, h) + aoff + m * 2048 + k * 1024); } while (0)
#define PG8_LDB(dst, b, h) do { _Pragma("unroll") for (int n = 0; n < 2; ++n) _Pragma("unroll") for (int k = 0; k < 2; ++k) dst[n][k] = *(const PG8_LAS bf16x8*)(lds + PG8_SB(b, h) + boff + n * 2048 + k * 1024); } while (0)
#define PG8_MMA(ai, bj, At, Bt) do { __builtin_amdgcn_s_setprio(1); _Pragma("unroll") for (int m = 0; m < 4; ++m) _Pragma("unroll") for (int n = 0; n < 2; ++n) _Pragma("unroll") for (int k = 0; k < 2; ++k) \
        acc[ai][bj][m][n] = __builtin_amdgcn_mfma_f32_16x16x32_bf16(Bt[n][k], At[m][k], acc[ai][bj][m][n], 0, 0, 0); __builtin_amdgcn_s_setprio(0); } while (0)
#define PG8_WAIT_V(n) asm volatile("s_waitcnt vmcnt(" #n ")" ::: "memory")
#define PG8_WAIT_L(n) asm volatile("s_waitcnt lgkmcnt(" #n ")" ::: "memory")
#define PG8_BAR __builtin_amdgcn_s_barrier()
#define PG8_SCHED __builtin_amdgcn_sched_barrier(0)
    Unit cur, nxt; int ui = 0;
    if (!S.next(0, cur)) return;
    f32x4 acc[2][2][4][2];
#pragma unroll
    for (int a = 0; a < 2; ++a)
#pragma unroll
        for (int b = 0; b < 2; ++b)
#pragma unroll
            for (int m = 0; m < 4; ++m)
#pragma unroll
                for (int n = 0; n < 2; ++n) acc[a][b][m][n] = (f32x4){0.f, 0.f, 0.f, 0.f};
    bf16x8 At[4][2], B0[2][2], B1[2][2];
    const char* cA = (const char*)g.A + (size_t)cur.pm * tstep; const char* cB = (const char*)g.Bt + (size_t)cur.pn * tstep;
    S.a_ready(cur);
    if constexpr (SP2) {
        PG8_STAGE(PG8_SB(0, 0), cB, voffB); PG8_STAGE(PG8_SB(0, 1), cB + hstep, voffB); PG8_STAGE_A(PG8_SA(0, 0), cA, 0, 0, 0); PG8_STAGE_A(PG8_SA(0, 1), cA + hstep, 0, 1, 0);
        if (wr == 1) PG8_BAR;
        PG8_WAIT_V(2); PG8_BAR;
        PG8_STAGE(PG8_SB(1, 0), cB + kstep, voffB); PG8_STAGE_A(PG8_SA(1, 0), cA + kstep, 0, 0, 1); PG8_STAGE(PG8_SB(1, 1), cB + hstep + kstep, voffB);
        PG8_WAIT_V(6); PG8_BAR;
    } else {
        PG8_STAGE(PG8_SB(0, 0), cB, voffB); PG8_STAGE_A(PG8_SA(0, 0), cA, 0, 0, 0); PG8_STAGE(PG8_SB(0, 1), cB + hstep, voffB); PG8_STAGE_A(PG8_SA(0, 1), cA + hstep, 0, 1, 0);
        if (wr == 1) PG8_BAR;
        PG8_WAIT_V(4); PG8_BAR;
        PG8_STAGE(PG8_SB(1, 0), cB + kstep, voffB); PG8_STAGE_A(PG8_SA(1, 0), cA + kstep, 0, 0, 1); PG8_STAGE(PG8_SB(1, 1), cB + hstep + kstep, voffB);
        PG8_WAIT_V(6); PG8_BAR;
    }
    for (;;) {
        const bool has_next = S.next(ui + 1, nxt);
        const char* nA = has_next ? (const char*)g.A + (size_t)nxt.pm * tstep : cA; const char* nB = has_next ? (const char*)g.Bt + (size_t)nxt.pn * tstep : cB;
#pragma nounroll
        for (int t = 0; t < nt; t += 2) {
            const bool last = (t == nt - 2);
            const int us2 = (last && has_next) ? ui + 1 : ui, kt2 = last ? 0 : t + 2;
            const char* a1 = cA + (size_t)(t + 1) * kstep;
            const char* a2 = last ? nA : cA + (size_t)(t + 2) * kstep; const char* b2 = last ? nB : cB + (size_t)(t + 2) * kstep;
            const char* a3 = a2 + kstep; const char* b3 = b2 + kstep;
            if (last && has_next) S.a_ready(nxt);
            if constexpr (SP2) {
            PG8_LDB(B0, 0, 0); PG8_LDB(B1, 0, 1); PG8_SCHED; PG8_LDA(At, 0, 0); PG8_STAGE_A(PG8_SA(1, 1), a1 + hstep, ui, 1, t + 1);
            PG8_WAIT_V(8); PG8_WAIT_L(0); PG8_BAR; PG8_MMA(0, 0, At, B0); PG8_MMA(0, 1, At, B1); PG8_BAR; PG8_SCHED;
            PG8_LDA(At, 0, 1); PG8_STAGE(PG8_SB(0, 0), b2, voffB); PG8_STAGE(PG8_SB(0, 1), b2 + hstep, voffB); PG8_STAGE_A(PG8_SA(0, 0), a2, us2, 0, kt2);
            PG8_WAIT_V(8); PG8_WAIT_L(0); PG8_BAR; PG8_MMA(1, 0, At, B0); PG8_MMA(1, 1, At, B1); PG8_BAR; PG8_SCHED;
            PG8_LDB(B0, 1, 0); PG8_LDB(B1, 1, 1); PG8_SCHED; PG8_LDA(At, 1, 0); PG8_STAGE_A(PG8_SA(0, 1), a2 + hstep, us2, 1, kt2);
            PG8_WAIT_V(8); PG8_WAIT_L(0); PG8_BAR; PG8_MMA(0, 0, At, B0); PG8_MMA(0, 1, At, B1); PG8_BAR; PG8_SCHED;
            PG8_LDA(At, 1, 1); PG8_STAGE(PG8_SB(1, 0), b3, voffB); PG8_STAGE(PG8_SB(1, 1), b3 + hstep, voffB); PG8_STAGE_A(PG8_SA(1, 0), a3, us2, 0, kt2 + 1);
            PG8_WAIT_V(8); PG8_WAIT_L(0); PG8_BAR; PG8_MMA(1, 0, At, B0); PG8_MMA(1, 1, At, B1); PG8_BAR; PG8_SCHED;
            } else {
            PG8_LDB(B0, 0, 0); PG8_SCHED; PG8_LDA(At, 0, 0); PG8_STAGE_A(PG8_SA(1, 1), a1 + hstep, ui, 1, t + 1);
            PG8_WAIT_L(8); PG8_BAR; PG8_WAIT_L(0); PG8_MMA(0, 0, At, B0); PG8_BAR; PG8_SCHED;
            PG8_LDB(B1, 0, 1); PG8_STAGE(PG8_SB(0, 0), b2, voffB);
            PG8_BAR; PG8_WAIT_L(0); PG8_MMA(0, 1, At, B1); PG8_BAR;
            PG8_LDA(At, 0, 1); PG8_STAGE_A(PG8_SA(0, 0), a2, us2, 0, kt2);
            PG8_BAR; PG8_WAIT_L(0); PG8_MMA(1, 0, At, B0); PG8_BAR; PG8_SCHED;
            PG8_STAGE(PG8_SB(0, 1), b2 + hstep, voffB);
            PG8_WAIT_V(6); PG8_BAR; PG8_MMA(1, 1, At, B1); PG8_BAR;
            PG8_LDB(B0, 1, 0); PG8_SCHED; PG8_LDA(At, 1, 0); PG8_STAGE_A(PG8_SA(0, 1), a2 + hstep, us2, 1, kt2);
            PG8_WAIT_L(8); PG8_BAR; PG8_WAIT_L(0); PG8_MMA(0, 0, At, B0); PG8_BAR; PG8_SCHED;
            PG8_LDB(B1, 1, 1); PG8_STAGE(PG8_SB(1, 0), b3, voffB);
            PG8_BAR; PG8_WAIT_L(0); PG8_MMA(0, 1, At, B1); PG8_BAR;
            PG8_LDA(At, 1, 1); PG8_STAGE_A(PG8_SA(1, 0), a3, us2, 0, kt2 + 1);
            PG8_BAR; PG8_WAIT_L(0); PG8_MMA(1, 0, At, B0); PG8_BAR; PG8_SCHED;
            PG8_STAGE(PG8_SB(1, 1), b3 + hstep, voffB);
            PG8_WAIT_V(6); PG8_BAR; PG8_MMA(1, 1, At, B1); PG8_BAR;
            }
        }
        if constexpr (ALIGN_EPI) { if (wr == 0) PG8_BAR; }
        if constexpr (!Epi::AFTER_DRAIN) { E(acc, cur, wr, wc, fr, fq); S.done(cur); }
        if (!has_next) break;
#pragma unroll
        for (int a = 0; a < 2; ++a)
#pragma unroll
            for (int b = 0; b < 2; ++b)
#pragma unroll
                for (int m = 0; m < 4; ++m)
#pragma unroll
                    for (int n = 0; n < 2; ++n) acc[a][b][m][n] = (f32x4){0.f, 0.f, 0.f, 0.f};
        cur = nxt; cA = nA; cB = nB; ++ui;
        if constexpr (ALIGN_EPI) { if (wr == 1) PG8_BAR; }
    }
    PG8_WAIT_V(0);
    if constexpr (!ALIGN_EPI) { if (wr == 0) PG8_BAR; }
    PG8_BAR;
    if constexpr (Epi::AFTER_DRAIN) { E.fused(acc, cur, wr, wc, fr, fq, lds, wid, lane); S.done(cur); }
#undef PG8_SA
#undef PG8_SB
#undef PG8_STAGE
#undef PG8_STAGE_A
#undef PG8_LDA
#undef PG8_LDB
#undef PG8_MMA
#undef PG8_WAIT_V
#undef PG8_WAIT_L
#undef PG8_BAR
#undef PG8_SCHED
}
}

#define XB_TMO      128
#define XB_XCNT(j)  (256  + 64 * (j))
#define XB_XSUB(j)  (1280 + 64 * (j))
#define XB_XGEN(j)  (2304 + 64 * (j))
#define XB_TOP      3328
#define XB_TOPGEN   3392
#define XCD_BAR_WORDS 3456
#define XB_SPIN_CAP (1u << 18)

__device__ __forceinline__ unsigned xb_ld(unsigned* p)              { return __hip_atomic_load(p, __ATOMIC_RELAXED, __HIP_MEMORY_SCOPE_AGENT); }
__device__ __forceinline__ unsigned xb_add(unsigned* p, unsigned v) { return __hip_atomic_fetch_add(p, v, __ATOMIC_RELAXED, __HIP_MEMORY_SCOPE_AGENT); }
__device__ __forceinline__ unsigned xb_xcc_id() { return (unsigned)__builtin_amdgcn_s_getreg((3 << 11) | 20) & 0xFu; }
#define XB_SPIN(cond, bar) do { unsigned _sp = 0; while (cond) { __builtin_amdgcn_s_sleep(1); \
    if ((++_sp & 255u) == 0u) { if (xb_ld(&(bar)[XB_TMO])) break; if (_sp > XB_SPIN_CAP) { atomicAdd(&(bar)[XB_TMO], 1u); break; } } } } while (0)

struct XcdBarrier {
    unsigned* bar; unsigned x;
    volatile LAS unsigned* st;
};

__device__ __forceinline__ XcdBarrier xcd_barrier_post(unsigned* bar, volatile LAS unsigned* st) {
    XcdBarrier b; b.bar = bar; b.x = xb_xcc_id(); b.st = st;
    if (threadIdx.x == 0) (void)xb_add(&bar[XB_XCNT(b.x)], 1u);
    return b;
}
__device__ __forceinline__ void xcd_barrier_complete(unsigned* bar, unsigned x, unsigned& nloc, unsigned& nx) {
    const unsigned G = gridDim.x * gridDim.y * gridDim.z;
    unsigned sum, cnt, mine, sp = 0u;
    for (;;) {
        sum = 0u; cnt = 0u; mine = 0u;
#pragma unroll
        for (unsigned j = 0; j < 16; ++j) { const unsigned c = xb_ld(&bar[XB_XCNT(j)]); sum += c; cnt += (c > 0u) ? 1u : 0u; mine = (j == x) ? c : mine; }
        if (sum == G) break;
        __builtin_amdgcn_s_sleep(1);
        if ((++sp & 255u) == 0u) { if (xb_ld(&bar[XB_TMO])) break; if (sp > XB_SPIN_CAP) { atomicAdd(&bar[XB_TMO], 1u); break; } }
    }
    nloc = mine > 0u ? mine : 1u; nx = cnt > 0u ? cnt : 1u;
}

__device__ __forceinline__ void xcd_barrier(const XcdBarrier& b) {
    asm volatile("s_waitcnt vmcnt(0)" ::: "memory");
    __syncthreads();
    if (threadIdx.x == 0) {
        unsigned* bar = b.bar;
        __builtin_amdgcn_s_waitcnt(0);
        unsigned nloc = b.st[0], nx = b.st[1];
        if (nloc == 0u) { xcd_barrier_complete(bar, b.x, nloc, nx); b.st[0] = nloc; b.st[1] = nx; }
        const unsigned old = xb_add(&bar[XB_XSUB(b.x)], 1u);
        const unsigned gen = old / nloc;
        if (old + 1u == (gen + 1u) * nloc) {
            __builtin_amdgcn_fence(__ATOMIC_RELEASE, "agent");
            asm volatile("s_waitcnt vmcnt(0)" ::: "memory");
            const unsigned og = xb_add(&bar[XB_TOP], 1u);
            const unsigned tg = og / nx;
            if (og + 1u == (tg + 1u) * nx) xb_add(&bar[XB_TOPGEN], 1u);
            else XB_SPIN(xb_ld(&bar[XB_TOPGEN]) == tg, bar);
            __builtin_amdgcn_fence(__ATOMIC_ACQUIRE, "agent");
            xb_add(&bar[XB_XGEN(b.x)], 1u);
            asm volatile("s_waitcnt vmcnt(0)" ::: "memory");
        } else {
            XB_SPIN(xb_ld(&bar[XB_XGEN(b.x)]) == gen, bar);
            __builtin_amdgcn_fence(__ATOMIC_ACQUIRE, "agent");
            asm volatile("s_waitcnt vmcnt(0)" ::: "memory");
        }
    }
    __syncthreads();
}


struct Args { const float* in[22]; float* out; unsigned char* ws; int ph_lo, ph_hi; };
static_assert(sizeof(Args) == 22 * 8 + 8 + 8 + 8, "Args has no padding");

struct DenseOrder {
    int nN, total, G, c;
    __device__ __forceinline__ bool next(int i, pg8::Unit& u) const { const int L = i * G + c; if (L >= total) return false; u.pm = L / nN; u.pn = L - u.pm * nN; return true; }
    __device__ __forceinline__ void a_ready(const pg8::Unit&) const {}
    __device__ __forceinline__ void done(const pg8::Unit&) const {}
};
struct MoeOrder {
    int NPN, total, G, c; const LAS int* tile_e; const LAS unsigned* tab;
    __device__ __forceinline__ bool next(int i, pg8::Unit& u) const { const int L = i * G + c; if (L >= total) return false; const int rt = L / NPN; u.pm = rt; u.pn = tile_e[rt] * NPN + (L - rt * NPN); return true; }
    __device__ __forceinline__ void a_ready(const pg8::Unit&) const {}
    __device__ __forceinline__ void done(const pg8::Unit&) const {}
    __device__ __forceinline__ const LAS unsigned* gtab() const { return tab; }
};

struct KvOrder {
    int G, c;
    __device__ __forceinline__ bool next(int i, pg8::Unit& u) const { int L;
        if (G == 256) { if (i < 2) L = i * 256 + c; else if (c >= 128 && i < 4) L = 512 + (i - 2) * 128 + (c - 128); else return false; }
        else { L = i * G + c; if (L >= (NTOK / 256) * 6) return false; }
        u.pm = L / 6; u.pn = L - u.pm * 6; return true; }
    __device__ __forceinline__ void a_ready(const pg8::Unit&) const {}
    __device__ __forceinline__ void done(const pg8::Unit&) const {}
};

typedef f32x4 Acc[2][2][4][2];
__device__ __forceinline__ u32x4 pack8(const f32x4 a, const f32x4 b) { u32x4 w; w.x = cvtpk(a[0], a[1]); w.y = cvtpk(a[2], a[3]); w.z = cvtpk(b[0], b[1]); w.w = cvtpk(b[2], b[3]); return w; }
__device__ __forceinline__ float dot4(const f32x4 a) { return (a[0] * a[0] + a[1] * a[1]) + (a[2] * a[2] + a[3] * a[3]); }
__device__ __forceinline__ void rope8(f32x4& v0, f32x4& v1, int pos, int i0) {
    float c, s;
    rope_cs(pos, i0, c, s);     { const float a = v0[0], b = v0[1]; v0[0] = a * c - b * s; v0[1] = b * c + a * s; }
    rope_cs(pos, i0 + 1, c, s); { const float a = v0[2], b = v0[3]; v0[2] = a * c - b * s; v0[3] = b * c + a * s; }
    rope_cs(pos, i0 + 2, c, s); { const float a = v1[0], b = v1[1]; v1[0] = a * c - b * s; v1[1] = b * c + a * s; }
    rope_cs(pos, i0 + 3, c, s); { const float a = v1[2], b = v1[3]; v1[2] = a * c - b * s; v1[3] = b * c + a * s; }
}

struct EpiU {
    static constexpr bool PERM = true, AFTER_DRAIN = false;
    bf16_t* P; bf16_t* CQ; bf16_t* CKV; float* ssq_q; float* ssq_kv;
    __device__ __forceinline__ void operator()(const Acc& acc, const pg8::Unit& u, int wr, int wc, int fr, int fq) const {
        const int pn = u.pn, row0 = u.pm * 256 + wr * 64 + fr, cl = wc * 32 + 8 * fq;
        bf16_t* O; int ld, cbase; float* sq = nullptr; int nslot = 0, slot = 0;
        if (pn == 0) { O = P; ld = POOLW; cbase = 0; }
        else if (pn < 3) { O = CQ; ld = QLORA; cbase = (pn - 1) * 256; sq = ssq_q; nslot = 8; slot = (pn - 1) * 4 + wc; }
        else { O = CKV; ld = KVLORA; cbase = 0; sq = ssq_kv; nslot = 4; slot = wc; }
#pragma unroll
        for (int ai = 0; ai < 2; ++ai)
#pragma unroll
            for (int m = 0; m < 4; ++m) { const int row = row0 + ai * 128 + m * 16; float s = 0.f;
#pragma unroll
                for (int bj = 0; bj < 2; ++bj) { const f32x4 v0 = acc[ai][bj][m][0], v1 = acc[ai][bj][m][1]; s += dot4(v0) + dot4(v1);
                    *(u32x4*)(O + (size_t)row * ld + cbase + bj * 128 + cl) = pack8(v0, v1); }
                if (sq) { s += __shfl_xor(s, 16); s += __shfl_xor(s, 32); if (fq == 0) sq[(size_t)row * nslot + slot] = s; } }
    }
};
struct EpiQ {
    static constexpr bool PERM = true, AFTER_DRAIN = false;
    bf16_t* Q; const float* ssq_q; const int* pos;
    __device__ __forceinline__ void operator()(const Acc& acc, const pg8::Unit& u, int wr, int wc, int fr, int fq) const {
        const int row0 = u.pm * 256 + wr * 64 + fr; constexpr float C2S = 0.07216878364870322f * 1.4426950408889634f;
#pragma unroll
        for (int ai = 0; ai < 2; ++ai)
#pragma unroll
            for (int m = 0; m < 4; ++m) { const int row = row0 + ai * 128 + m * 16; const f32x4 s0 = *(const f32x4*)(ssq_q + (size_t)row * 8), s1 = *(const f32x4*)(ssq_q + (size_t)row * 8 + 4);
                const float ss = ((s0[0] + s0[1]) + (s0[2] + s0[3])) + ((s1[0] + s1[1]) + (s1[2] + s1[3]));
                const float rs = C2S / sqrtf(ss * (1.f / QLORA) + EPS); const int b = row / SEQ, s = row - b * SEQ; const int p = pos[row];
#pragma unroll
                for (int bj = 0; bj < 2; ++bj) { const int c0 = u.pn * 256 + bj * 128 + wc * 32 + 8 * fq; if (c0 >= UQW) continue;
                    const int h = c0 / DQK, d = c0 - h * DQK; f32x4 v0 = acc[ai][bj][m][0] * rs, v1 = acc[ai][bj][m][1] * rs;
                    if (d >= DNOPE) rope8(v0, v1, p, (d - DNOPE) >> 1);
                    *(u32x4*)(Q + ((size_t)(b * NH + h) * SEQ + s) * DQK + d) = pack8(v0, v1); } }
    }
};
struct EpiKV {
    static constexpr bool PERM = true, AFTER_DRAIN = false;
    bf16_t* Kb; bf16_t* Vb; const float* ssq_kv;
    __device__ __forceinline__ void operator()(const Acc& acc, const pg8::Unit& u, int wr, int wc, int fr, int fq) const {
        const int row0 = u.pm * 256 + wr * 64 + fr, h = u.pn, d = wc * 32 + 8 * fq;
#pragma unroll
        for (int ai = 0; ai < 2; ++ai)
#pragma unroll
            for (int m = 0; m < 4; ++m) { const int row = row0 + ai * 128 + m * 16; const f32x4 s0 = *(const f32x4*)(ssq_kv + (size_t)row * 4);
                const float rs = 1.f / sqrtf(((s0[0] + s0[1]) + (s0[2] + s0[3])) * (1.f / KVLORA) + EPS); const int b = row / SEQ, s = row - b * SEQ; const size_t tr = (size_t)(b * NH + h) * SEQ + s;
                *(u32x4*)(Kb + tr * DQK + d) = pack8(acc[ai][0][m][0] * rs, acc[ai][0][m][1] * rs);
                *(u32x4*)(Vb + tr * DV + d) = pack8(acc[ai][1][m][0] * rs, acc[ai][1][m][1] * rs); }
    }
};
struct EpiO {
    static constexpr bool PERM = true, AFTER_DRAIN = false;
    const float* x; bf16_t* x1; const float* gate; float* ssq;
    __device__ __forceinline__ void operator()(const Acc& acc, const pg8::Unit& u, int wr, int wc, int fr, int fq) const {
        const int row0 = u.pm * 256 + wr * 64 + fr, col0 = u.pn * 256 + wc * 32 + 8 * fq, b = (u.pm * 256) / SEQ;
        f32x4 gv[2][2];
#pragma unroll
        for (int bj = 0; bj < 2; ++bj)
#pragma unroll
            for (int n = 0; n < 2; ++n) gv[bj][n] = *(const f32x4*)(gate + (size_t)b * (NMOD * DM) + col0 + bj * 128 + n * 4);
#pragma unroll
        for (int ai = 0; ai < 2; ++ai)
#pragma unroll
            for (int m = 0; m < 4; ++m) { const int row = row0 + ai * 128 + m * 16; const size_t off = (size_t)row * DM + col0; float s = 0.f;
#pragma unroll
                for (int bj = 0; bj < 2; ++bj) { const f32x4 x0 = *(const f32x4*)(x + off + bj * 128), x4 = *(const f32x4*)(x + off + bj * 128 + 4);
                    const f32x4 o0 = x0 + gv[bj][0] * acc[ai][bj][m][0], o1 = x4 + gv[bj][1] * acc[ai][bj][m][1]; s += dot4(o0) + dot4(o1);
                    *(u32x4*)(x1 + off + bj * 128) = pack8(o0, o1); }
                s += __shfl_xor(s, 16); s += __shfl_xor(s, 32); if (fq == 0) ssq[(size_t)row * 16 + u.pn * 4 + wc] = s; }
    }
};
struct EpiGU {
    static constexpr bool PERM = true, AFTER_DRAIN = false;
    bf16_t* ACT;
    __device__ __forceinline__ void operator()(const Acc& acc, const pg8::Unit& u, int wr, int wc, int fr, int fq) const {
        const int row0 = u.pm * 256 + wr * 64 + fr, col = (u.pn & 1) * 128 + wc * 32 + 8 * fq;
#pragma unroll
        for (int ai = 0; ai < 2; ++ai)
#pragma unroll
            for (int m = 0; m < 4; ++m) { const int row = row0 + ai * 128 + m * 16; f32x4 o[2];
#pragma unroll
                for (int n = 0; n < 2; ++n) { const f32x4 g = acc[ai][0][m][n], v = acc[ai][1][m][n];
#pragma unroll
                    for (int e = 0; e < 4; ++e) o[n][e] = g[e] / (1.f + __expf(-g[e])) * v[e]; }
                *(u32x4*)(ACT + (size_t)row * DEXP + col) = pack8(o[0], o[1]); }
    }
};
struct EpiDown {
    static constexpr bool PERM = true, AFTER_DRAIN = false;
    bf16_t* YS;
    __device__ __forceinline__ void operator()(const Acc& acc, const pg8::Unit& u, int wr, int wc, int fr, int fq) const {
        const int row0 = u.pm * 256 + wr * 64 + fr, col = (u.pn & 3) * 256 + wc * 32 + 8 * fq;
#pragma unroll
        for (int ai = 0; ai < 2; ++ai)
#pragma unroll
            for (int m = 0; m < 4; ++m) { const int row = row0 + ai * 128 + m * 16;
#pragma unroll
                for (int bj = 0; bj < 2; ++bj) *(u32x4*)(YS + (size_t)row * DM + col + bj * 128) = pack8(acc[ai][bj][m][0], acc[ai][bj][m][1]); }
    }
};

namespace att {
constexpr int QB = 256, KVBLK = 64, KPITCH = 400;
constexpr int SHM_V = KVBLK * DV * 2, SHM_K = KVBLK * KPITCH;
constexpr int OFF_V = 0, OFF_K = 2 * SHM_V, OFF_WS = OFF_K + 2 * SHM_K;
constexpr int LDS_NEED = OFF_WS + 8 * 64 * 4;
static_assert(LDS_NEED <= RING_BYTES, "attention scratch inside the ring");
constexpr float THR = 11.0f;
constexpr int NUNIT = NB * NH * (SEQ / QB);

__device__ __forceinline__ int v_st(int k, int c) { const int kk = (k & ~0xC) | ((k & 4) << 1) | ((k & 8) >> 1); return ((kk >> 3) * 4 + (c >> 5)) * 512 + ((kk & 7) * 32 + (c & 31)) * 2; }
__device__ __forceinline__ int v_rd_base(int lane) { return ((lane & 3) << 3) | (((lane >> 2) & 3) << 6) | (((lane >> 4) & 1) << 5) | (((lane >> 5) & 1) << 8); }
constexpr int v_rd_off(int d0, int ks, int half) { return d0 * 512 + ks * 4096 + half * 2048; }
__device__ __forceinline__ int crow(int r, int hi) { return (r & 3) + 8 * (r >> 2) + 4 * hi; }

__device__ __forceinline__ void mask_tile(f32x16& p0, f32x16& p1, int dq) {
    const float NEG = -__builtin_inff();
#pragma unroll
    for (int r = 0; r < 16; ++r) { const int c = (r & 3) + 8 * (r >> 2); if (dq - c < 0) p0[r] = NEG; if (dq - c - 32 < 0) p1[r] = NEG; }
}
__device__ __forceinline__ void softmax_tile(f32x16& p0, f32x16& p1, float& m_reg, float& alpha, float& l_reg, bf16x8& pa0, bf16x8& pa1, bf16x8& pa2, bf16x8& pa3) {
    float pmax = p0[0];
#pragma unroll
    for (int r = 1; r < 16; ++r) pmax = fmaxf(pmax, p0[r]);
#pragma unroll
    for (int r = 0; r < 16; ++r) pmax = fmaxf(pmax, p1[r]);
    { auto rr = __builtin_amdgcn_permlane32_swap(__float_as_uint(pmax), __float_as_uint(pmax), false, false); pmax = fmaxf(__uint_as_float(rr[0]), __uint_as_float(rr[1])); }
    float mn;
    if (__builtin_expect(__all(pmax - m_reg <= THR), 1)) { mn = m_reg; alpha = 1.f; }
    else { mn = fmaxf(m_reg, pmax); alpha = __builtin_amdgcn_exp2f(m_reg - mn); m_reg = mn; }
#pragma unroll
    for (int r = 0; r < 16; ++r) { p0[r] = __builtin_amdgcn_exp2f(p0[r] - mn); p1[r] = __builtin_amdgcn_exp2f(p1[r] - mn); }
    float ps = 0.f;
#pragma unroll
    for (int r = 0; r < 16; ++r) ps += p0[r];
#pragma unroll
    for (int r = 0; r < 16; ++r) ps += p1[r];
    { auto rr = __builtin_amdgcn_permlane32_swap(__float_as_uint(ps), __float_as_uint(ps), false, false); ps = __uint_as_float(rr[0]) + __uint_as_float(rr[1]); }
    l_reg = l_reg * alpha + ps;
#define PK4(P, B_, OUT) do { unsigned a0 = cvtpk(P[B_+0], P[B_+1]), a1 = cvtpk(P[B_+2], P[B_+3]); unsigned b0 = cvtpk(P[B_+4], P[B_+5]), b1 = cvtpk(P[B_+6], P[B_+7]); \
        auto r0 = __builtin_amdgcn_permlane32_swap(a0, b0, false, false); auto r1 = __builtin_amdgcn_permlane32_swap(a1, b1, false, false); \
        u32x4 w = {r0[0], r1[0], r0[1], r1[1]}; OUT = __builtin_bit_cast(bf16x8, w); } while (0)
    PK4(p0, 0, pa0); PK4(p0, 8, pa1); PK4(p1, 0, pa2); PK4(p1, 8, pa3);
#undef PK4
}
__device__ __forceinline__ void qkt(f32x16& p0, f32x16& p1, const LAS unsigned char* kb, const bf16x8* qr) {
    p0 = f32x16{}; p1 = f32x16{};
#pragma unroll
    for (int d0 = 0; d0 < 12; ++d0) {
        const bf16x8 b0 = *(const LAS bf16x8*)(kb + d0 * 32);
        const bf16x8 b1 = *(const LAS bf16x8*)(kb + d0 * 32 + 32 * KPITCH);
        p0 = __builtin_amdgcn_mfma_f32_32x32x16_bf16(b0, qr[d0], p0, 0, 0, 0);
        p1 = __builtin_amdgcn_mfma_f32_32x32x16_bf16(b1, qr[d0], p1, 0, 0, 0); }
}
__device__ __forceinline__ void pv_tile(f32x16* o, int vb, bf16x8 pa0, bf16x8 pa1, bf16x8 pa2, bf16x8 pa3) {
#define TRRD(dst, off) asm volatile("ds_read_b64_tr_b16 %0, %1 offset:%2" : "=&v"(dst) : "v"(vb), "i"(off) : "memory")
#define PV_D0(d0) do { s16x4 l0, l1, l2, l3, h0, h1, h2, h3; constexpr int b_ = v_rd_off(d0, 0, 0); \
        TRRD(l0, b_); TRRD(h0, b_ + 2048); TRRD(l1, b_ + 4096); TRRD(h1, b_ + 6144); TRRD(l2, b_ + 8192); TRRD(h2, b_ + 10240); TRRD(l3, b_ + 12288); TRRD(h3, b_ + 14336); \
        asm volatile("s_waitcnt lgkmcnt(0)" ::: "memory"); SBAR(); \
        o[d0] = __builtin_amdgcn_mfma_f32_32x32x16_bf16(pa0, (bf16x8){l0[0], l0[1], l0[2], l0[3], h0[0], h0[1], h0[2], h0[3]}, o[d0], 0, 0, 0); \
        o[d0] = __builtin_amdgcn_mfma_f32_32x32x16_bf16(pa1, (bf16x8){l1[0], l1[1], l1[2], l1[3], h1[0], h1[1], h1[2], h1[3]}, o[d0], 0, 0, 0); \
        o[d0] = __builtin_amdgcn_mfma_f32_32x32x16_bf16(pa2, (bf16x8){l2[0], l2[1], l2[2], l2[3], h2[0], h2[1], h2[2], h2[3]}, o[d0], 0, 0, 0); \
        o[d0] = __builtin_amdgcn_mfma_f32_32x32x16_bf16(pa3, (bf16x8){l3[0], l3[1], l3[2], l3[3], h3[0], h3[1], h3[2], h3[3]}, o[d0], 0, 0, 0); } while (0)
    PV_D0(0); PV_D0(1); PV_D0(2); PV_D0(3);
#undef PV_D0
#undef TRRD
}

__device__ __forceinline__ void attn_unit(int bh, int qb, const bf16_t* __restrict__ Q, const bf16_t* __restrict__ K, const bf16_t* __restrict__ V, bf16_t* MIX, LAS unsigned char* lds) {
    const int tid = threadIdx.x, wid = __builtin_amdgcn_readfirstlane(tid >> 6), lane = tid & 63, r32 = lane & 31, hi = lane >> 5;
    const int NT = 4 * qb + 4;
    const bf16_t* Qh = Q + ((size_t)bh * SEQ + (size_t)qb * QB) * DQK; const bf16_t* Kh = K + (size_t)bh * SEQ * DQK; const bf16_t* Vh = V + (size_t)bh * SEQ * DV;
    LAS float* ws = (LAS float*)(lds + OFF_WS) + wid * 64; LAS float* li_l = ws; LAS float* al_l = ws + 32;
    bf16x8 qr[12];
#pragma unroll
    for (int d0 = 0; d0 < 12; ++d0) qr[d0] = *(const bf16x8*)(Qh + (size_t)(wid * 32 + r32) * DQK + d0 * 16 + hi * 8);
    const int sr = tid >> 4, sc = (tid & 15) * 8, vst0 = v_st(sr, sc), vst1 = v_st(32 + sr, sc);
    int kst[3];
#pragma unroll
    for (int i = 0; i < 3; ++i) { const int c = tid + 512 * i, key = c / 24, ch = c - key * 24; kst[i] = key * KPITCH + ch * 16; }
    bf16x8 sk[3], sv0, sv1;
#define GLOAD(t) do { const bf16_t* kp = Kh + (size_t)(t) * KVBLK * DQK; const bf16_t* vp = Vh + (size_t)(t) * KVBLK * DV; \
        _Pragma("unroll") for (int i = 0; i < 3; ++i) sk[i] = *(const bf16x8*)(kp + (size_t)(tid + 512 * i) * 8); \
        sv0 = *(const bf16x8*)(vp + (size_t)sr * DV + sc); sv1 = *(const bf16x8*)(vp + (size_t)(32 + sr) * DV + sc); } while (0)
#define SWRITE(bf) do { _Pragma("unroll") for (int i = 0; i < 3; ++i) *(LAS bf16x8*)(lds + OFF_K + (bf) * SHM_K + kst[i]) = sk[i]; \
        *(LAS bf16x8*)(lds + OFF_V + (bf) * SHM_V + vst0) = sv0; *(LAS bf16x8*)(lds + OFF_V + (bf) * SHM_V + vst1) = sv1; } while (0)
    const int qlo = qb * QB + wid * 32, qm = qlo + r32 - 4 * hi;
    const int vb0 = (int)(size_t)(lds + OFF_V) + v_rd_base(lane);
    const LAS unsigned char* kb0 = lds + OFF_K + r32 * KPITCH + hi * 16;
    float m_reg = -1e30f, l_reg = 0.f; f32x16 o[4] = {};
    GLOAD(0); SWRITE(0);
#pragma unroll
    for (int d0 = 0; d0 < 12; ++d0) asm volatile("" :: "v"(qr[d0]));
    __syncthreads();
    for (int t = 0; t < NT; ++t) {
        const int cur = t & 1; const bool more = t + 1 < NT;
        if (more) GLOAD(t + 1);
        const int kbase = t * KVBLK;
        if (kbase <= qlo + 31) {
            f32x16 p0, p1; float alpha; bf16x8 pa0, pa1, pa2, pa3;
            qkt(p0, p1, kb0 + cur * SHM_K, qr);
            if (kbase + KVBLK - 1 > qlo) mask_tile(p0, p1, qm - kbase);
            softmax_tile(p0, p1, m_reg, alpha, l_reg, pa0, pa1, pa2, pa3);
            if (__any(alpha < 1.f)) { if (hi == 0) al_l[r32] = alpha; LDS_WAIT();
#pragma unroll
                for (int d_ = 0; d_ < 4; ++d_)
#pragma unroll
                    for (int r = 0; r < 16; ++r) o[d_][r] *= al_l[crow(r, hi)]; }
            pv_tile(o, vb0 + cur * SHM_V, pa0, pa1, pa2, pa3);
        }
        if (more) SWRITE(cur ^ 1);
        __syncthreads();
    }
#undef GLOAD
#undef SWRITE
    if (hi == 0) li_l[r32] = l_reg; LDS_WAIT();
    const int b = bh / NH, h = bh - b * NH;
    bf16_t* Ow = MIX + ((size_t)b * SEQ + (size_t)qb * QB + wid * 32) * DM + POOLW + h * DV;
#pragma unroll
    for (int r = 0; r < 16; ++r) { const int orow = crow(r, hi); const float rl = __builtin_amdgcn_rcpf(li_l[orow]);
#pragma unroll
        for (int d0 = 0; d0 < 4; ++d0) { const float v = o[d0][r] * rl; const float vn = __shfl_xor(v, 1);
            if ((r32 & 1) == 0) *(unsigned*)(Ow + (size_t)orow * DM + d0 * 32 + r32) = cvtpk(v, vn); } }
    __syncthreads();
}
}

struct Frame {
    LAS unsigned char* lds; gu32* ctl; unsigned char* ws;
    int tid, lane, wave, vcu, G;
    float* out;
};
#define WSP(T, off) ((T*)(F.ws + (off)))
#define INP A.in

struct RowMap { int kind, base;
    __device__ __forceinline__ int operator()(int n) const {
        if (kind == 1) { if (n < 1024) return n; const int j = n - 1024; return 1024 + (j < 32 ? 2 * j : 2 * (j - 32) + 1); }
        if (kind == 2) { const int h = n / DQK, d = n - h * DQK; if (d < DNOPE) return n; const int j = d - DNOPE; return h * DQK + DNOPE + (j < 32 ? 2 * j : 2 * (j - 32) + 1); }
        if (kind == 3) { if (n < 256) return base + (n >> 7) * 256 + (n & 127); const int j = n - 256; return base + (j >> 7) * 256 + 128 + (j & 127); }
        return base + n; } };
__device__ __forceinline__ void transpose_item(const float* W, int K, int N, bf16_t* WT, const float* kscale, const RowMap rm, LAS float* scr, int item, int lane) {
    const int nblk = N / 32, kb = item / nblk, nb = item - kb * nblk, k0 = 64 * kb, n0 = 32 * nb;
    float tv[32];
#pragma unroll
    for (int i = 0; i < 32; ++i) tv[i] = W[(size_t)(k0 + 2 * i + (lane >> 5)) * N + n0 + (lane & 31)];
#pragma unroll
    for (int i = 0; i < 32; ++i) scr[(2 * i + (lane >> 5)) * 33 + (lane & 31)] = tv[i];
    LDS_WAIT(); asm volatile("" ::: "memory");
    const int c = lane & 7; float ks[8];
#pragma unroll
    for (int j = 0; j < 8; ++j) ks[j] = kscale ? kscale[k0 + 8 * c + j] : 1.f;
#pragma unroll
    for (int j = 0; j < 4; ++j) { const int n = (lane >> 3) + 8 * j; const LAS float* s = scr + (8 * c) * 33 + n;
        u32x4 o; o.x = cvtpk(s[0 * 33] * ks[0], s[1 * 33] * ks[1]); o.y = cvtpk(s[2 * 33] * ks[2], s[3 * 33] * ks[3]); o.z = cvtpk(s[4 * 33] * ks[4], s[5 * 33] * ks[5]); o.w = cvtpk(s[6 * 33] * ks[6], s[7 * 33] * ks[7]);
        *(u32x4*)(WT + (size_t)rm(n0 + n) * K + k0 + 8 * c) = o; }
    LDS_WAIT(); asm volatile("" ::: "memory");
}
__device__ __forceinline__ void phase_prologue(const Frame& F, const Args& A) {
    const float* c = INP[1]; const float* w_mod = INP[3]; const float* b_mod = INP[4];
    float* mod = WSP(float, WS_MOD);
    if (F.vcu < 96) {
        LAS float* cact = (LAS float*)F.lds; LAS float* red = (LAS float*)(F.lds + 32768);
        for (int i = F.tid; i < NB * DM; i += NTHR) { const float v = c[i]; cact[i] = v / (1.f + expf(-v)); }
        __syncthreads();
        for (int cg = F.vcu; cg < 96; cg += F.G) {
            float acc[NB];
#pragma unroll
            for (int b = 0; b < NB; ++b) acc[b] = 0.f;
            const float* wp = w_mod + (size_t)(F.wave * 128) * (NMOD * DM) + cg * 64 + F.lane;
#pragma unroll 16
            for (int k = 0; k < 128; ++k) { const float wv = wp[(size_t)k * (NMOD * DM)];
#pragma unroll
                for (int b = 0; b < NB; ++b) acc[b] += cact[b * DM + F.wave * 128 + k] * wv; }
#pragma unroll
            for (int b = 0; b < NB; ++b) red[(F.wave * NB + b) * 64 + F.lane] = acc[b];
            __syncthreads();
            if (F.wave == 0) {
#pragma unroll
                for (int b = 0; b < NB; ++b) { float s = 0.f;
#pragma unroll
                    for (int w = 0; w < NWAVES; ++w) s += red[(w * NB + b) * 64 + F.lane];
                    mod[b * (NMOD * DM) + cg * 64 + F.lane] = s + b_mod[cg * 64 + F.lane]; } }
            __syncthreads();
        }
    }
    __syncthreads();
    LAS float* scr = (LAS float*)(F.lds + F.wave * 16384);
    const int gw = F.vcu * NWAVES + F.wave, NGW = F.G * NWAVES;
    constexpr int I_IN = (DM / 64) * (INW / 32), I_UQ = (QLORA / 64) * (UQW / 32), I_UKV = (KVLORA / 64) * (UKVW / 32), I_O = (DM / 64) * (DM / 32);
    constexpr int I_GU1 = (DM / 64) * (2 * DEXP / 32), I_D1 = (DEXP / 64) * (DM / 32);
    constexpr int NITEMS = I_IN + I_UQ + I_UKV + I_O + NEXP * I_GU1 + NEXP * I_D1;
    for (int it = gw; it < NITEMS; it += NGW) {
        int r = it;
        if (r < I_IN) { transpose_item(INP[6], DM, INW, WSP(bf16_t, WS_WIN), nullptr, RowMap{1, 0}, scr, r, F.lane); continue; } r -= I_IN;
        if (r < I_UQ) { transpose_item(INP[10], QLORA, UQW, WSP(bf16_t, WS_WUQ), INP[9], RowMap{2, 0}, scr, r, F.lane); continue; } r -= I_UQ;
        if (r < I_UKV) { transpose_item(INP[12], KVLORA, UKVW, WSP(bf16_t, WS_WUKV), INP[11], RowMap{0, 0}, scr, r, F.lane); continue; } r -= I_UKV;
        if (r < I_O) { transpose_item(INP[13], DM, DM, WSP(bf16_t, WS_WO), nullptr, RowMap{0, 0}, scr, r, F.lane); continue; } r -= I_O;
        if (r < NEXP * I_GU1) { const int e = r / I_GU1; transpose_item(INP[19] + (size_t)e * DM * 2 * DEXP, DM, 2 * DEXP, WSP(bf16_t, WS_WGU), nullptr, RowMap{3, e * 512}, scr, r - e * I_GU1, F.lane); continue; } r -= NEXP * I_GU1;
        { const int e = r / I_D1; transpose_item(INP[20] + (size_t)e * DEXP * DM, DEXP, DM, WSP(bf16_t, WS_WD), nullptr, RowMap{0, e * DM}, scr, r - e * I_D1, F.lane); }
    }
    { float* WRo = WSP(float, WS_WR); const float* wg = INP[15]; const float* wr = INP[17];
        for (int i = F.vcu * NTHR + F.tid; i < DM * 48; i += F.G * NTHR) { const int k = i / 48, cc = i - k * 48; float v = 0.f; if (cc < 4) v = wg[k * 4 + cc]; else if (cc < 36) v = wr[k * 32 + cc - 4]; WRo[i] = v; } }
    { const int gt = F.vcu * NTHR + F.tid, NGT = F.G * NTHR; const u32x4 z = {0u, 0u, 0u, 0u};
        u32x4* p2 = (u32x4*)(WSP(bf16_t, WS_WUQ) + (size_t)UQW * QLORA); constexpr int n2 = (UQW_PAD - UQW) * QLORA / 8;
        for (int i = gt; i < n2; i += NGT) p2[i] = z; }
}

__device__ __forceinline__ void phase_h(const Frame& F, const Args& A) {
    const float* x = INP[0]; const float* g = INP[5]; const float* mod = WSP(float, WS_MOD); bf16_t* H = WSP(bf16_t, WS_H);
    for (int t = F.vcu * NWAVES + F.wave; t < NTOK / 16; t += F.G * NWAVES) {
        const int row0 = t * 16, b = row0 / SEQ; const float* md = mod + (size_t)b * (NMOD * DM);
        f32x4 gs[4], sh[4];
#pragma unroll
        for (int j = 0; j < 4; ++j) { const int col = 4 * F.lane + 256 * j; gs[j] = *(const f32x4*)(g + col) * (*(const f32x4*)(md + DM + col) + 1.f); sh[j] = *(const f32x4*)(md + col); }
#pragma unroll 4
        for (int r = 0; r < 16; ++r) { const float* xr = x + (size_t)(row0 + r) * DM; f32x4 v[4]; float s = 0.f;
#pragma unroll
            for (int j = 0; j < 4; ++j) { v[j] = *(const f32x4*)(xr + 4 * F.lane + 256 * j); s += dot4(v[j]); }
            const float rstd = 1.f / sqrtf(wave_sum(s) * (1.f / DM) + EPS);
#pragma unroll
            for (int j = 0; j < 4; ++j) { const f32x4 o = v[j] * rstd * gs[j] + sh[j]; u32x2 w; w.x = cvtpk(o[0], o[1]); w.y = cvtpk(o[2], o[3]);
                *(u32x2*)(H + (size_t)(row0 + r) * DM + 4 * F.lane + 256 * j) = w; } }
    }
}

__device__ __forceinline__ bf16x8 ld_lds16(const LAS unsigned char* p) { return *(const LAS bf16x8*)p; }
template <int G_>
__device__ __forceinline__ void pool_group(const LAS unsigned char* PT, const LAS unsigned char* WPT, int jr, int q, int l15, int spos, const float* pscale, bf16_t* mixrow0, int lane) {
    constexpr int W = 2 << G_;
    const float inv = 1.f / (float)(spos + 1 < W ? spos + 1 : W);
    bf16x8 A[2];
#pragma unroll
    for (int kk = 0; kk < 2; ++kk) { const int ch0 = G_ * 64 + kk * 32 + 8 * q; float a8[8], own[8];
#pragma unroll
        for (int e = 0; e < 8; ++e) a8[e] = 0.f;
#pragma unroll
        for (int j = 0; j < W; ++j) { const u32x4 w = __builtin_bit_cast(u32x4, ld_lds16(PT + (jr - j) * 528 + ch0 * 2));
            const float f[8] = {bf_lo(w.x), bf_hi(w.x), bf_lo(w.y), bf_hi(w.y), bf_lo(w.z), bf_hi(w.z), bf_lo(w.w), bf_hi(w.w)};
#pragma unroll
            for (int e = 0; e < 8; ++e) { a8[e] += f[e]; if (j == 0) own[e] = f[e]; } }
        u32x4 pk; pk.x = cvtpk(a8[0] * inv - own[0], a8[1] * inv - own[1]); pk.y = cvtpk(a8[2] * inv - own[2], a8[3] * inv - own[3]);
        pk.z = cvtpk(a8[4] * inv - own[4], a8[5] * inv - own[5]); pk.w = cvtpk(a8[6] * inv - own[6], a8[7] * inv - own[7]);
        A[kk] = __builtin_bit_cast(bf16x8, pk); }
#pragma unroll
    for (int nt = 0; nt < 4; ++nt) { f32x4 acc = {0.f, 0.f, 0.f, 0.f};
#pragma unroll
        for (int kk = 0; kk < 2; ++kk) { const bf16x8 B = ld_lds16(WPT + (G_ * 64 + nt * 16 + l15) * 144 + (kk * 32 + 8 * q) * 2);
            acc = __builtin_amdgcn_mfma_f32_16x16x32_bf16(A[kk], B, acc, 0, 0, 0); }
        const int col = G_ * 64 + nt * 16 + l15; const float ps = pscale[col];
#pragma unroll
        for (int r = 0; r < 4; ++r) { const float v = acc[r] * ps; const float vn = __shfl_xor(v, 1);
            if ((lane & 1) == 0) *(unsigned*)(mixrow0 + (size_t)(4 * q + r) * DM + col) = cvtpk(v, vn); } }
}
__device__ __forceinline__ void phase_pool(const Frame& F, const Args& A) {
    const bf16_t* P = WSP(bf16_t, WS_P); const float* w_pool = INP[7]; const float* pscale = INP[8]; bf16_t* MIX = WSP(bf16_t, WS_MIX);
    LAS unsigned char* PT = F.lds; LAS unsigned char* WPT = F.lds + 76800;
    for (int i = F.tid; i < 4 * 64 * 64; i += NTHR) { const int g = i >> 12, cc = (i >> 6) & 63, d = i & 63;
        *(LAS bf16_t*)(WPT + (g * 64 + d) * 144 + cc * 2) = (bf16_t)(cvtpk(w_pool[i], 0.f) & 0xffffu); }
    for (int tb = F.vcu; tb < NTOK / 128; tb += F.G) {
        const int row0 = tb * 128, b = row0 / SEQ, s0 = row0 - b * SEQ;
        __syncthreads();
        for (int i = F.tid; i < 143 * 32; i += NTHR) { const int j = i >> 5, ch = i & 31, s = s0 - 15 + j;
            u32x4 v = {0u, 0u, 0u, 0u}; if (s >= 0) v = *(const u32x4*)(P + ((size_t)b * SEQ + s) * POOLW + ch * 8);
            *(LAS u32x4*)(PT + j * 528 + ch * 16) = v; }
        __syncthreads();
        const int l15 = F.lane & 15, q = F.lane >> 4, tok = 16 * F.wave + l15, jr = tok + 15, spos = s0 + tok;
        bf16_t* mixrow0 = MIX + (size_t)(row0 + 16 * F.wave) * DM;
        pool_group<0>(PT, WPT, jr, q, l15, spos, pscale, mixrow0, F.lane);
        pool_group<1>(PT, WPT, jr, q, l15, spos, pscale, mixrow0, F.lane);
        pool_group<2>(PT, WPT, jr, q, l15, spos, pscale, mixrow0, F.lane);
        pool_group<3>(PT, WPT, jr, q, l15, spos, pscale, mixrow0, F.lane);
    }
    __syncthreads();
}


__device__ __forceinline__ void phase_krope(const Frame& F, const Args& A) {
    const bf16_t* H = WSP(bf16_t, WS_H); const bf16_t* Wk = WSP(bf16_t, WS_WIN) + (size_t)1024 * DM; bf16_t* Kb = WSP(bf16_t, WS_K); const int* pos = (const int*)INP[2];
    LAS unsigned char* WL = F.lds;
    __syncthreads();
    for (int i = F.tid; i < 64 * 128; i += NTHR) { const int n = i >> 7, ch = i & 127; *(LAS u32x4*)(WL + n * 2064 + ch * 16) = *(const u32x4*)(Wk + (size_t)n * DM + ch * 8); }
    __syncthreads();
    const int l15 = F.lane & 15, q = F.lane >> 4;
    for (int tb = F.vcu; tb < NTOK / 128; tb += F.G) {
        const int row0 = tb * 128 + 16 * F.wave; const bf16_t* hr = H + (size_t)(row0 + l15) * DM + 8 * q;
        f32x4 acc[4] = {{0.f, 0.f, 0.f, 0.f}, {0.f, 0.f, 0.f, 0.f}, {0.f, 0.f, 0.f, 0.f}, {0.f, 0.f, 0.f, 0.f}};
#pragma unroll 2
        for (int k8 = 0; k8 < 4; ++k8) { bf16x8 av[8];
#pragma unroll
            for (int j = 0; j < 8; ++j) av[j] = *(const bf16x8*)(hr + (k8 * 8 + j) * 32);
#pragma unroll
            for (int j = 0; j < 8; ++j)
#pragma unroll
                for (int nt = 0; nt < 4; ++nt) { const bf16x8 bv = *(const LAS bf16x8*)(WL + (nt * 16 + l15) * 2064 + ((k8 * 8 + j) * 32 + 8 * q) * 2);
                    acc[nt] = __builtin_amdgcn_mfma_f32_16x16x32_bf16(av[j], bv, acc[nt], 0, 0, 0); } }
#pragma unroll
        for (int r = 0; r < 4; ++r) { const int row = row0 + 4 * q + r, b = row / SEQ, s = row - b * SEQ; const int p = pos[row];
#pragma unroll
            for (int nt = 0; nt < 4; ++nt) { const int c = nt * 16 + l15; float cs, sn; rope_cs(p, c >> 1, cs, sn);
                const float own = acc[nt][r], oth = __shfl_xor(own, 1); const float o = (l15 & 1) ? own * cs + oth * sn : own * cs - oth * sn; const float on = __shfl_xor(o, 1);
                if ((l15 & 1) == 0) { const unsigned w = cvtpk(o, on);
#pragma unroll
                    for (int h = 0; h < NH; ++h) *(unsigned*)(Kb + ((size_t)(b * NH + h) * SEQ + s) * DQK + DNOPE + c) = w; } } }
    }
    __syncthreads();
}

__device__ __forceinline__ void phase_attn(const Frame& F, const Args& A) {
    const bf16_t* Q = WSP(bf16_t, WS_Q); const bf16_t* K = WSP(bf16_t, WS_K); const bf16_t* V = WSP(bf16_t, WS_V); bf16_t* MIX = WSP(bf16_t, WS_MIX);
    volatile LAS int* mbox = (volatile LAS int*)(F.lds + LX_MBOX);
    for (;;) {
        if (F.tid == 0) mbox[0] = (int)__hip_atomic_fetch_add((unsigned*)(F.ctl + CW_ATTNQ), 1u, __ATOMIC_RELAXED, __HIP_MEMORY_SCOPE_AGENT);
        __syncthreads();
        const int u = mbox[0];
        __syncthreads();
        if (u >= att::NUNIT) break;
        const int qb = 15 - u / (NB * NH), bh = u % (NB * NH);
        att::attn_unit(bh, qb, Q, K, V, MIX, F.lds);
    }
}

__device__ __forceinline__ void phase_route(const Frame& F, const Args& A) {
    const bf16_t* X1 = WSP(bf16_t, WS_X1B); const float* ssq = WSP(float, WS_SSQX); const float* mod = WSP(float, WS_MOD); const float* gffn = INP[14];
    const float* b_group = INP[16]; const float* b_router = INP[18]; const float* WR = WSP(float, WS_WR);
    bf16_t* H2 = WSP(bf16_t, WS_H); int* ltok = WSP(int, WS_LTOK); unsigned* tinfo = WSP(unsigned, WS_TINFO); float* tw = WSP(float, WS_TW);
    LAS float* GS = (LAS float*)(F.lds + 53248); LAS float* SH = (LAS float*)(F.lds + 57344);
    LAS float* LOG = (LAS float*)(F.lds + 61440) + F.wave * (16 * 48);
    LAS int* LCNT = (LAS int*)(F.lds + 86016); LAS int* LBASE = (LAS int*)(F.lds + 86144);
    const int l15 = F.lane & 15, q = F.lane >> 4;
    int wsrc[3], wdst[3];
#pragma unroll
    for (int j = 0; j < 3; ++j) { const int idx = F.tid + NTHR * j, kl = idx / 12, c4 = idx - kl * 12; wsrc[j] = kl * 48 + c4 * 4; wdst[j] = kl * 208 + c4 * 16; }
    for (int tb = F.vcu; tb < NTOK / 128; tb += F.G) {
        const int row0 = tb * 128, b = row0 / SEQ; const float* md = mod + (size_t)b * (NMOD * DM);
        __syncthreads();
        for (int k = F.tid; k < DM; k += NTHR) { GS[k] = gffn[k] * (1.f + md[4 * DM + k]); SH[k] = md[3 * DM + k]; }
        if (F.tid < NEXP) LCNT[F.tid] = 0;
        const int row = row0 + 16 * F.wave + l15;
        float rstd; { const float* sp = ssq + (size_t)row * 16; const f32x4 a = *(const f32x4*)sp, b4 = *(const f32x4*)(sp + 4), c4 = *(const f32x4*)(sp + 8), d4 = *(const f32x4*)(sp + 12);
            const float ss = (((a[0] + a[1]) + (a[2] + a[3])) + ((b4[0] + b4[1]) + (b4[2] + b4[3]))) + (((c4[0] + c4[1]) + (c4[2] + c4[3])) + ((d4[0] + d4[1]) + (d4[2] + d4[3])));
            rstd = 1.f / sqrtf(ss * (1.f / DM) + EPS); }
        const bf16_t* xr = X1 + (size_t)row * DM + 8 * q;
        f32x4 wreg[3]; u32x4 xreg[4], xnxt[4];
#pragma unroll
        for (int j = 0; j < 3; ++j) wreg[j] = *(const f32x4*)(WR + wsrc[j]);
#pragma unroll
        for (int i = 0; i < 4; ++i) xreg[i] = *(const u32x4*)(xr + 32 * i);
#pragma unroll
        for (int j = 0; j < 3; ++j) *(LAS f32x4*)(F.lds + wdst[j]) = wreg[j];
        __syncthreads();
        f32x4 acc[3] = {{0.f, 0.f, 0.f, 0.f}, {0.f, 0.f, 0.f, 0.f}, {0.f, 0.f, 0.f, 0.f}};
#pragma unroll
        for (int c = 0; c < 8; ++c) {
            const LAS float* WL = (const LAS float*)(F.lds + (c & 1) * 26624);
            if (c < 7) {
#pragma unroll
                for (int j = 0; j < 3; ++j) wreg[j] = *(const f32x4*)(WR + (c + 1) * (128 * 48) + wsrc[j]);
#pragma unroll
                for (int i = 0; i < 4; ++i) xnxt[i] = *(const u32x4*)(xr + (c + 1) * 128 + 32 * i); }
#pragma unroll
            for (int i = 0; i < 4; ++i) { const int kk = c * 128 + 32 * i + 8 * q;
                const f32x4 g0 = *(const LAS f32x4*)(GS + kk), g1 = *(const LAS f32x4*)(GS + kk + 4), s0 = *(const LAS f32x4*)(SH + kk), s1 = *(const LAS f32x4*)(SH + kk + 4);
                const u32x4 xw = xreg[i];
                const f32x4 xa = {bf_lo(xw.x), bf_hi(xw.x), bf_lo(xw.y), bf_hi(xw.y)}, xb = {bf_lo(xw.z), bf_hi(xw.z), bf_lo(xw.w), bf_hi(xw.w)};
                const f32x4 ha = xa * rstd * g0 + s0, hb = xb * rstd * g1 + s1;
                *(u32x4*)(H2 + (size_t)row * DM + kk) = pack8(ha, hb);
#pragma unroll
                for (int e = 0; e < 8; ++e) { const LAS float* wl = WL + (32 * i + 8 * q + e) * 52 + l15; const float hv = e < 4 ? ha[e & 3] : hb[e & 3];
#pragma unroll
                    for (int t = 0; t < 3; ++t) acc[t] = __builtin_amdgcn_mfma_f32_16x16x4f32(hv, wl[t * 16], acc[t], 0, 0, 0); } }
            if (c < 7) {
#pragma unroll
                for (int j = 0; j < 3; ++j) *(LAS f32x4*)(F.lds + ((c + 1) & 1) * 26624 + wdst[j]) = wreg[j];
#pragma unroll
                for (int i = 0; i < 4; ++i) xreg[i] = xnxt[i]; }
            __syncthreads();
        }
#pragma unroll
        for (int t = 0; t < 3; ++t)
#pragma unroll
            for (int r = 0; r < 4; ++r) LOG[(4 * q + r) * 48 + t * 16 + l15] = acc[t][r];
        LDS_WAIT(); asm volatile("" ::: "memory");
        int e_sel[2] = {0, 0}, rank[2] = {0, 0}; float wsel[2] = {0.f, 0.f};
        if (F.lane < 16) {
            const LAS float* L = LOG + F.lane * 48;
            float gl[4], ge[4], ein[8], eb[8];
#pragma unroll
            for (int j = 0; j < 4; ++j) gl[j] = L[j];
            const float gmx = fmaxf(fmaxf(gl[0], gl[1]), fmaxf(gl[2], gl[3])); float gsum = 0.f;
#pragma unroll
            for (int j = 0; j < 4; ++j) { ge[j] = expf(gl[j] - gmx); gsum += ge[j]; }
            int gsel = 0; float gbest = gl[0] + b_group[0], gesel = ge[0];
#pragma unroll
            for (int j = 1; j < 4; ++j) { const float v = gl[j] + b_group[j]; if (v > gbest) { gbest = v; gsel = j; gesel = ge[j]; } }
            const float gp = gesel / gsum;
#pragma unroll
            for (int j = 0; j < 8; ++j) { ein[j] = L[4 + gsel * 8 + j]; eb[j] = ein[j] + b_router[gsel * 8 + j]; }
            float b1 = eb[0], e1 = ein[0]; int i1 = 0;
#pragma unroll
            for (int j = 1; j < 8; ++j) if (eb[j] > b1) { b1 = eb[j]; e1 = ein[j]; i1 = j; }
            float b2 = -__builtin_inff(), e2 = 0.f; int i2 = 0;
#pragma unroll
            for (int j = 0; j < 8; ++j) if (j != i1 && eb[j] > b2) { b2 = eb[j]; e2 = ein[j]; i2 = j; }
            const float mx = fmaxf(e1, e2), x1 = expf(e1 - mx), x2 = expf(e2 - mx), den = x1 + x2;
            wsel[0] = gp * (x1 / den); wsel[1] = gp * (x2 / den);
            e_sel[0] = gsel * 8 + i1; e_sel[1] = gsel * 8 + i2;
            rank[0] = __hip_atomic_fetch_add(LCNT + e_sel[0], 1, __ATOMIC_RELAXED, __HIP_MEMORY_SCOPE_WORKGROUP);
            rank[1] = __hip_atomic_fetch_add(LCNT + e_sel[1], 1, __ATOMIC_RELAXED, __HIP_MEMORY_SCOPE_WORKGROUP);
        }
        __syncthreads();
        if (F.tid < NEXP) { const int n = LCNT[F.tid]; LBASE[F.tid] = n > 0 ? (int)__hip_atomic_fetch_add((unsigned*)(F.ctl + CW_ECNT + 64 * F.tid), (unsigned)n, __ATOMIC_RELAXED, __HIP_MEMORY_SCOPE_AGENT) : 0; }
        __syncthreads();
        if (F.lane < 16) { const int tok = row0 + 16 * F.wave + F.lane;
#pragma unroll
            for (int k = 0; k < 2; ++k) { const int e = e_sel[k], p = LBASE[e] + rank[k]; ltok[(size_t)e * NTOK + p] = tok; tinfo[tok * 2 + k] = (unsigned)e | ((unsigned)p << 8); tw[tok * 2 + k] = wsel[k]; } }
    }
    __syncthreads();
}

__device__ __forceinline__ int moe_tables(const Frame& F, const Args& A) {
    LAS int* ECNT = (LAS int*)(F.lds + LX_ECNT); LAS int* TBASE = (LAS int*)(F.lds + LX_TBASE); LAS int* TILEE = (LAS int*)(F.lds + LX_TILEE);
    __syncthreads();
    if (F.tid < NEXP) ECNT[F.tid] = (int)__hip_atomic_load((unsigned*)(F.ctl + CW_ECNT + 64 * F.tid), __ATOMIC_RELAXED, __HIP_MEMORY_SCOPE_AGENT);
    __syncthreads();
    if (F.tid == 0) { int s = 0; for (int e = 0; e < NEXP; ++e) { TBASE[e] = s; s += (ECNT[e] + 255) >> 8; } TBASE[NEXP] = s; }
    __syncthreads();
    const int nrt = TBASE[NEXP];
    for (int rt = F.tid; rt < nrt; rt += NTHR) { int e = 0; for (int j = 1; j < NEXP; ++j) if (TBASE[j] <= rt) e = j; TILEE[rt] = e; }
    __syncthreads();
    return nrt;
}

__device__ __forceinline__ void phase_final(const Frame& F, const Args& A) {
    float* X = F.out; const bf16_t* X1 = WSP(bf16_t, WS_X1B); const float* mod = WSP(float, WS_MOD); const float* fg = INP[21]; const bf16_t* YS = WSP(bf16_t, WS_YS);
    const unsigned* tinfo = WSP(unsigned, WS_TINFO); const float* tw = WSP(float, WS_TW);
    (void)moe_tables(F, A);
    const LAS int* TBASE = (const LAS int*)(F.lds + LX_TBASE);
    for (int t = F.vcu * NWAVES + F.wave; t < NTOK / 16; t += F.G * NWAVES) {
        const int row0 = t * 16, b = row0 / SEQ; const float* md = mod + (size_t)b * (NMOD * DM);
        f32x4 gf[4], fgv[4];
#pragma unroll
        for (int j = 0; j < 4; ++j) { const int col = 4 * F.lane + 256 * j; gf[j] = *(const f32x4*)(md + 5 * DM + col); fgv[j] = *(const f32x4*)(fg + col); }
        unsigned ti = 0u; float twv = 0.f;
        if (F.lane < 32) { ti = tinfo[row0 * 2 + F.lane]; twv = tw[row0 * 2 + F.lane]; }
        const int srow = TBASE[ti & 255u] * 256 + (int)(ti >> 8);
#pragma unroll
        for (int rg = 0; rg < 16; rg += 4) {
            u32x2 xv[4][4], ya[4][4], yc[4][4]; float w0[4], w1[4];
#pragma unroll
            for (int rr = 0; rr < 4; ++rr) { const int r = rg + rr, row = row0 + r;
                const size_t r0 = (size_t)__builtin_amdgcn_readlane(srow, 2 * r), r1 = (size_t)__builtin_amdgcn_readlane(srow, 2 * r + 1);
                w0[rr] = __uint_as_float(__builtin_amdgcn_readlane(__float_as_uint(twv), 2 * r)); w1[rr] = __uint_as_float(__builtin_amdgcn_readlane(__float_as_uint(twv), 2 * r + 1));
#pragma unroll
                for (int j = 0; j < 4; ++j) { const int col = 4 * F.lane + 256 * j; xv[rr][j] = *(const u32x2*)(X1 + (size_t)row * DM + col);
                    ya[rr][j] = *(const u32x2*)(YS + r0 * DM + col); yc[rr][j] = *(const u32x2*)(YS + r1 * DM + col); } }
#pragma unroll
            for (int rr = 0; rr < 4; ++rr) { const int row = row0 + rg + rr; f32x4 v[4]; float s = 0.f;
#pragma unroll
                for (int j = 0; j < 4; ++j) { const u32x2 a = ya[rr][j], c = yc[rr][j]; f32x4 y;
                    y[0] = w0[rr] * bf_lo(a.x) + w1[rr] * bf_lo(c.x); y[1] = w0[rr] * bf_hi(a.x) + w1[rr] * bf_hi(c.x); y[2] = w0[rr] * bf_lo(a.y) + w1[rr] * bf_lo(c.y); y[3] = w0[rr] * bf_hi(a.y) + w1[rr] * bf_hi(c.y);
                    const u32x2 xw = xv[rr][j]; const f32x4 xf = {bf_lo(xw.x), bf_hi(xw.x), bf_lo(xw.y), bf_hi(xw.y)};
                    v[j] = xf + gf[j] * y; s += dot4(v[j]); }
                const float rstd = 1.f / sqrtf(wave_sum(s) * (1.f / DM) + EPS);
#pragma unroll
                for (int j = 0; j < 4; ++j) *(f32x4*)(X + (size_t)row * DM + 4 * F.lane + 256 * j) = v[j] * rstd * fgv[j]; }
        }
    }
}

#ifndef MK_N_LAUNCHES
#define MK_N_LAUNCHES 1
#endif
constexpr int NPH = 10;

__global__ void __launch_bounds__(NTHR, 2) fwd_kernel(Args A) {
    extern __shared__ __attribute__((aligned(16))) unsigned char lds_raw[];
    Frame F;
    F.lds = (LAS unsigned char*)lds_raw; F.ws = A.ws; F.ctl = (gu32*)(A.ws + WS_CTL);
    F.tid = threadIdx.x; F.lane = F.tid & 63; F.wave = __builtin_amdgcn_readfirstlane(F.tid >> 6);
    F.G = gridDim.x; { const int bx = blockIdx.x; F.vcu = (F.G % 8 == 0) ? (bx % 8) * (F.G / 8) + bx / 8 : bx; }
    F.out = A.out;
    for (int u = F.tid; u < (LDS_BYTES - LX_BASE) / 4; u += NTHR) ((LAS unsigned*)(F.lds + LX_BASE))[u] = 0u;
    __syncthreads();
    const int lo = A.ph_lo, hi = A.ph_hi;
    XcdBarrier bar; bar.bar = (unsigned*)(F.ctl + CW_BAR); bar.x = 0; bar.st = nullptr;
    if (hi - lo > 1) bar = xcd_barrier_post((unsigned*)(F.ctl + CW_BAR), (volatile LAS unsigned*)(F.lds + LX_MISC));
#ifndef PH_MASK
#define PH_MASK 0x3ff
#endif
#define IN(k) (((PH_MASK >> (k)) & 1) && lo <= (k) && (k) < hi)
#define SEAM(k) do { if (IN(k) && IN((k) + 1)) xcd_barrier(bar); } while (0)

    if (IN(0)) { phase_prologue(F, A); } SEAM(0);
    if (IN(1)) { phase_h(F, A); } SEAM(1);
    if (IN(2)) {
        pg8::Gemm g{WSP(bf16_t, WS_H), WSP(bf16_t, WS_WIN), NTOK, 1024, DM}; DenseOrder S{4, (NTOK / 256) * 4, F.G, F.vcu};
        EpiU E{WSP(bf16_t, WS_P), WSP(bf16_t, WS_CQ), WSP(bf16_t, WS_CKV), WSP(float, WS_SSQQ), WSP(float, WS_SSQKV)};
        pg8::gemm_phase<EpiU, DenseOrder, true, true, false>(F.lds, g, S, E);
    } SEAM(2);
    if (IN(3)) {
        { pg8::Gemm g{WSP(bf16_t, WS_CQ), WSP(bf16_t, WS_WUQ), NTOK, UQW_PAD, QLORA}; DenseOrder S{UQW_PAD / 256, (NTOK / 256) * (UQW_PAD / 256), F.G, F.vcu};
          EpiQ E{WSP(bf16_t, WS_Q), WSP(float, WS_SSQQ), (const int*)A.in[2]};
          pg8::gemm_phase<EpiQ, DenseOrder, true, true, false>(F.lds, g, S, E); }
        { pg8::Gemm g{WSP(bf16_t, WS_CKV), WSP(bf16_t, WS_WUKV), NTOK, UKVW, KVLORA}; KvOrder S{F.G, F.vcu};
          EpiKV E{WSP(bf16_t, WS_K), WSP(bf16_t, WS_V), WSP(float, WS_SSQKV)};
          pg8::gemm_phase<EpiKV, KvOrder, true, true, false>(F.lds, g, S, E); }
        phase_pool(F, A);
        phase_krope(F, A);
    } SEAM(3);
    if (IN(4)) { phase_attn(F, A); } SEAM(4);
    if (IN(5)) {
        pg8::Gemm g{WSP(bf16_t, WS_MIX), WSP(bf16_t, WS_WO), NTOK, DM, DM}; DenseOrder S{DM / 256, (NTOK / 256) * (DM / 256), F.G, F.vcu};
        EpiO E{A.in[0], WSP(bf16_t, WS_X1B), WSP(float, WS_MOD) + 2 * DM, WSP(float, WS_SSQX)};
        pg8::gemm_phase<EpiO, DenseOrder, true, true, false>(F.lds, g, S, E);
    } SEAM(5);
    if (IN(6)) { phase_route(F, A); } SEAM(6);
    if (IN(7)) {
        const int nrt = moe_tables(F, A);
        const LAS int* ECNT = (const LAS int*)(F.lds + LX_ECNT); const LAS int* TBASE = (const LAS int*)(F.lds + LX_TBASE); const LAS int* TILEE = (const LAS int*)(F.lds + LX_TILEE);
        LAS unsigned* GTAB = (LAS unsigned*)(F.lds + LX_GTAB); const int* ltok = WSP(int, WS_LTOK);
        const int total = nrt * 2;
        for (int i = 0; i < 4; ++i) { const int L = i * F.G + F.vcu;
            if (L < total && F.tid < 256) { const int rt = L >> 1, e = TILEE[rt], p = 256 * (rt - TBASE[e]) + F.tid;
                const int tok = p < ECNT[e] ? ltok[(size_t)e * NTOK + p] : 0; GTAB[i * 256 + F.tid] = (unsigned)tok * (unsigned)(DM * 2); } }
        __syncthreads();
        pg8::Gemm g{WSP(bf16_t, WS_H), WSP(bf16_t, WS_WGU), NTOK, NEXP * 512, DM}; MoeOrder S{2, total, F.G, F.vcu, TILEE, GTAB};
        EpiGU E{WSP(bf16_t, WS_ACT)};
        pg8::gemm_phase<EpiGU, MoeOrder, true, true, true>(F.lds, g, S, E);
    } SEAM(7);
    if (IN(8)) {
        const int nrt = moe_tables(F, A);
        const LAS int* TILEE = (const LAS int*)(F.lds + LX_TILEE);
        pg8::Gemm g{WSP(bf16_t, WS_ACT), WSP(bf16_t, WS_WD), MAXRT * 256, NEXP * DM, DEXP}; MoeOrder S{4, nrt * 4, F.G, F.vcu, TILEE, nullptr};
        EpiDown E{WSP(bf16_t, WS_YS)};
        pg8::gemm_phase<EpiDown, MoeOrder, true, true, false>(F.lds, g, S, E);
    } SEAM(8);
    if (IN(9)) { phase_final(F, A); }
#undef IN
#undef SEAM
}

extern "C" void kernel_launch(void* const* d_in, const int* in_sizes, int n_in, void* d_out, int out_size, void* d_ws, size_t ws_size, hipStream_t stream) {
    static int grid = 0;
    if (grid == 0) {
        if (n_in != 22 || in_sizes[0] != NTOK * DM || out_size != NTOK * DM || ws_size < WS_END) {
            fprintf(stderr, "kernel_launch: built for 22 inputs, x/out of %d floats, >= %zu bytes of workspace; got n_in %d, in0 %d, out %d, ws %zu; nothing launched\n", NTOK * DM, (size_t)WS_END, n_in, n_in > 0 ? in_sizes[0] : -1, out_size, ws_size);
            grid = -1; return; }
        int dev = 0, cus = 0, per_cu = 0;
        if (hipGetDevice(&dev) != hipSuccess || hipDeviceGetAttribute(&cus, hipDeviceAttributeMultiprocessorCount, dev) != hipSuccess) { fprintf(stderr, "kernel_launch: device query failed\n"); grid = -1; return; }
        if (hipFuncSetAttribute((const void*)fwd_kernel, hipFuncAttributeMaxDynamicSharedMemorySize, LDS_BYTES) != hipSuccess) { fprintf(stderr, "kernel_launch: hipFuncSetAttribute failed\n"); grid = -1; return; }
        if (hipOccupancyMaxActiveBlocksPerMultiprocessor(&per_cu, (const void*)fwd_kernel, NTHR, LDS_BYTES) != hipSuccess || per_cu < 1)
            fprintf(stderr, "kernel_launch: note: occupancy query reports %d workgroups per CU\n", per_cu);
        (void)hipGetLastError();
        grid = cus;
    }
    if (grid < 0) return;
    if (hipMemsetAsync((char*)d_ws + WS_CTL, 0, CTL_ZERO_BYTES, stream) != hipSuccess) { fprintf(stderr, "kernel_launch: hipMemsetAsync failed\n"); return; }
    Args a{};
    for (int i = 0; i < 22; ++i) a.in[i] = (const float*)d_in[i];
    a.out = (float*)d_out; a.ws = (unsigned char*)d_ws;
    if (MK_N_LAUNCHES == 1) { a.ph_lo = 0; a.ph_hi = NPH; hipLaunchKernelGGL(fwd_kernel, dim3(grid), dim3(NTHR), LDS_BYTES, stream, a); }
    else for (int p = 0; p < NPH; ++p) { a.ph_lo = p; a.ph_hi = p + 1; hipLaunchKernelGGL(fwd_kernel, dim3(grid), dim3(NTHR), LDS_BYTES, stream, a); }
    const hipError_t le = hipPeekAtLastError();
    if (le != hipSuccess) fprintf(stderr, "kernel_launch: launch failed: %s\n", hipGetErrorName(le));
}
```
